# Optimizing an MI355X kernel written in HIP

```python
import jax, jax.numpy as jnp
from jax import lax
import numpy as np

D_MODEL = 2048
BATCH = 4
SEQ = 2048
DEPTH = 4

N_HEADS = 16
HEAD_DIM = D_MODEL // N_HEADS
D_FF = 4 * D_MODEL
N_META = 16
BLOCK = 128
N_A_LAYERS = DEPTH // 2
N_B_LAYERS = DEPTH - N_A_LAYERS
RMS_EPS = 1e-6
FGATE_BIAS_LO = 1.0
FGATE_BIAS_HI = 6.0

kernel_name = "yoco_fox_stickbreak_hybrid"


def rms_norm(x, g):
    xf = x.astype(jnp.float32)
    y = xf * lax.rsqrt(jnp.mean(xf * xf, axis=-1, keepdims=True) + RMS_EPS)
    return (y * g.astype(jnp.float32)).astype(x.dtype)


def split_heads(t):
    b, l, _ = t.shape
    return t.reshape(b, l, N_HEADS, HEAD_DIM)


def query_blocks(total_len):
    bounds = [(0, N_META)]
    for start in range(N_META, total_len, BLOCK):
        bounds.append((start, min(start + BLOCK, total_len)))
    return bounds


def forgetting_attention(q, k, v, cum_logf):
    scale = HEAD_DIM ** -0.5
    outs = []
    for qs, qe in query_blocks(q.shape[1]):
        s = jnp.einsum('bqhd,bkhd->bhqk', q[:, qs:qe], k[:, :qe]).astype(jnp.float32) * scale
        s = s + cum_logf[:, :, qs:qe, None] - cum_logf[:, :, None, :qe]
        q_pos = jnp.arange(qs, qe)
        k_pos = jnp.arange(qe)
        mask = k_pos[None, :] <= q_pos[:, None]
        s = jnp.where(mask, s, -jnp.inf)
        p = jax.nn.softmax(s, axis=-1).astype(v.dtype)
        outs.append(jnp.einsum('bhqk,bkhd->bqhd', p, v[:, :qe]))
    return jnp.concatenate(outs, axis=1)


def stick_breaking_attention(q, k, v):
    scale = HEAD_DIM ** -0.5
    outs = []
    for qs, qe in query_blocks(q.shape[1]):
        z = jnp.einsum('bqhd,bkhd->bhqk', q[:, qs:qe], k[:, :qe]).astype(jnp.float32) * scale
        q_pos = jnp.arange(qs, qe)
        k_pos = jnp.arange(qe)
        mask = k_pos[None, :] < q_pos[:, None]
        log_beta = jax.nn.log_sigmoid(z)
        log_one_minus = jnp.where(mask, jax.nn.log_sigmoid(-z), 0.0)
        suffix = lax.cumsum(log_one_minus, axis=3, reverse=True) - log_one_minus
        a = jnp.where(mask, jnp.exp(log_beta + suffix), 0.0).astype(v.dtype)
        outs.append(jnp.einsum('bhqk,bkhd->bqhd', a, v[:, :qe]))
    return jnp.concatenate(outs, axis=1)


def squared_relu_mlp(h, w_up, w_down):
    u = h @ w_up
    return jnp.square(jax.nn.relu(u)) @ w_down


def setup_inputs(seed: int = 0) -> dict:
    key = jax.random.key(seed)
    ks = jax.random.split(key, 16)
    f32 = jnp.float32
    d_in_scale = D_MODEL ** -0.5
    x = jax.random.normal(ks[0], (BATCH, SEQ, D_MODEL), f32)
    meta_tokens = jax.random.normal(ks[1], (N_META, D_MODEL), f32)
    norm_attn = 1.0 + 0.02 * jax.random.normal(ks[2], (DEPTH, D_MODEL), f32)
    norm_mlp = 1.0 + 0.02 * jax.random.normal(ks[3], (DEPTH, D_MODEL), f32)
    w_up = jax.random.normal(ks[4], (DEPTH, D_MODEL, D_FF), f32) * d_in_scale
    w_down = jax.random.normal(ks[5], (DEPTH, D_FF, D_MODEL), f32) * (D_FF ** -0.5)
    fox_w_in = jax.random.normal(ks[6], (N_A_LAYERS, D_MODEL, 3 * D_MODEL + N_HEADS), f32) * d_in_scale
    fox_b_f = (jnp.linspace(FGATE_BIAS_LO, FGATE_BIAS_HI, N_HEADS, dtype=f32)[None, :]
               + 0.1 * jax.random.normal(ks[7], (N_A_LAYERS, N_HEADS), f32))
    fox_w_o = jax.random.normal(ks[8], (N_A_LAYERS, D_MODEL, D_MODEL), f32) * d_in_scale
    kv_norm = 1.0 + 0.02 * jax.random.normal(ks[9], (D_MODEL,), f32)
    w_kv = jax.random.normal(ks[10], (D_MODEL, 2 * D_MODEL), f32) * d_in_scale
    sb_w_q = jax.random.normal(ks[11], (N_B_LAYERS, D_MODEL, D_MODEL), f32) * d_in_scale
    sb_w_o = jax.random.normal(ks[12], (N_B_LAYERS, D_MODEL, D_MODEL), f32) * d_in_scale
    final_norm = 1.0 + 0.02 * jax.random.normal(ks[13], (D_MODEL,), f32)
    return {"x": x, "meta_tokens": meta_tokens, "norm_attn": norm_attn, "norm_mlp": norm_mlp,
            "w_up": w_up, "w_down": w_down, "fox_w_in": fox_w_in, "fox_b_f": fox_b_f,
            "fox_w_o": fox_w_o, "kv_norm": kv_norm, "w_kv": w_kv, "sb_w_q": sb_w_q,
            "sb_w_o": sb_w_o, "final_norm": final_norm}


def reference(x, meta_tokens, norm_attn, norm_mlp, w_up, w_down, fox_w_in, fox_b_f, fox_w_o,
              kv_norm, w_kv, sb_w_q, sb_w_o, final_norm):
    b = x.shape[0]
    meta = jnp.broadcast_to(meta_tokens[None].astype(x.dtype), (b, N_META, D_MODEL))
    h = jnp.concatenate([meta, x], axis=1)
    length = h.shape[1]
    shared_k = None
    shared_v = None
    for layer in range(DEPTH):
        a = rms_norm(h, norm_attn[layer])
        if layer < N_A_LAYERS:
            i = layer
            proj = a @ fox_w_in[i]
            q, k, v, f_logit = jnp.split(proj, [D_MODEL, 2 * D_MODEL, 3 * D_MODEL], axis=-1)
            logf = jax.nn.log_sigmoid(f_logit.astype(jnp.float32) + fox_b_f[i].astype(jnp.float32))
            cum_logf = jnp.cumsum(logf, axis=1).transpose(0, 2, 1)
            o = forgetting_attention(split_heads(q), split_heads(k), split_heads(v), cum_logf)
            h = h + o.reshape(b, length, D_MODEL) @ fox_w_o[i]
        else:
            if layer == N_A_LAYERS:
                c = rms_norm(h, kv_norm)
                k_s, v_s = jnp.split(c @ w_kv, 2, axis=-1)
                shared_k = split_heads(k_s)
                shared_v = split_heads(v_s)
            i = layer - N_A_LAYERS
            q = split_heads(a @ sb_w_q[i])
            o = stick_breaking_attention(q, shared_k, shared_v)
            h = h + o.reshape(b, length, D_MODEL) @ sb_w_o[i]
        h = h + squared_relu_mlp(rms_norm(h, norm_mlp[layer]), w_up[layer], w_down[layer])
    return rms_norm(h, final_norm)[:, N_META:]
```

```cpp
#include <hip/hip_runtime.h>
#include <hip/hip_cooperative_groups.h>
#include <cstdio>
#include <cstdint>
namespace cg = cooperative_groups;

#ifndef NAIVE_GEMM
#define NAIVE_GEMM 0
#endif
#ifndef NAIVE_FOX
#define NAIVE_FOX 0
#endif
#ifndef NAIVE_SB
#define NAIVE_SB 0
#endif

#ifndef GEMM_SP2
#define GEMM_SP2 1
#endif
#ifndef DUP_STEP
#define DUP_STEP 0
#endif
#ifndef DUP_STEP_AT
#define DUP_STEP_AT 3
#endif
#ifndef DUP_RES
#define DUP_RES 0
#endif
#ifndef DUP_PMMASK
#define DUP_PMMASK 0
#endif
#ifndef DUP_BAR
#define DUP_BAR 0
#endif
#ifndef DUP_P0
#define DUP_P0 0
#endif
#ifndef DUP_FOX
#define DUP_FOX 0
#endif
#ifndef DUP_SB
#define DUP_SB 0
#endif
#ifndef DUP_UP
#define DUP_UP 0
#endif
#define LAS __attribute__((address_space(3)))
#define DI __device__ __forceinline__
typedef unsigned short bf16_t;
typedef short bf16x8 __attribute__((ext_vector_type(8)));
typedef float f32x4 __attribute__((ext_vector_type(4)));
typedef float f32x16 __attribute__((ext_vector_type(16)));
typedef unsigned u32x4 __attribute__((ext_vector_type(4)));
typedef unsigned u32x2 __attribute__((ext_vector_type(2)));

constexpr int D = 2048, NB = 4, SEQ = 2048, NH = 16, DH = 128, FF = 8192, NMETA = 16;
constexpr int MR = NB * SEQ;
constexpr int LP = 2112;
constexpr int MOFF = 48, ROFF = 64;
constexpr int NIN = 3 * D + NH;
constexpr int VLD = NB * LP;
constexpr float EPS = 1e-6f;
constexpr float LOG2E = 1.4426950408889634f;
constexpr float QSCALE = 0.08838834764831845f * LOG2E;
constexpr int NTHR = 512;
constexpr int LDS_BYTES = 147456;

constexpr size_t SZ_DD = (size_t)D * D * 2;
constexpr size_t WS_WT_IN = 0;
constexpr size_t WS_WF = WS_WT_IN + 2 * 3 * SZ_DD;
constexpr size_t WS_WT_O = WS_WF + 2 * 16 * D * 2;
constexpr size_t WS_WT_UP = WS_WT_O + 2 * SZ_DD;
constexpr size_t WS_WT_DN = WS_WT_UP + 4 * 4 * SZ_DD;
constexpr size_t WS_WT_QKV2 = WS_WT_DN + 4 * 4 * SZ_DD;
constexpr size_t WS_WT_Q3 = WS_WT_QKV2 + 3 * SZ_DD;
constexpr size_t WS_WT_SO = WS_WT_Q3 + SZ_DD;
constexpr size_t WS_H = WS_WT_SO + 2 * SZ_DD;
constexpr size_t WS_HB = WS_H + (size_t)MR * D * 4;
constexpr size_t WS_QB = WS_HB + (size_t)MR * D * 2;
constexpr size_t WS_KB = WS_QB + (size_t)MR * D * 2;
constexpr size_t WS_VT = WS_KB + (size_t)NB * LP * D * 2;
constexpr size_t WS_OB = WS_VT + (size_t)D * VLD * 2;
constexpr size_t WS_UB = WS_OB + (size_t)MR * D * 2;
constexpr size_t WS_SSQ = WS_UB + (size_t)MR * FF * 2;
constexpr size_t WS_LF = WS_SSQ + 9 * (size_t)MR * 8;
constexpr size_t WS_HM = WS_LF + (size_t)NB * NH * LP * 4;
constexpr size_t WS_HBM = WS_HM + 16 * D * 4;
constexpr size_t WS_QM = WS_HBM + 16 * D * 2;
constexpr size_t WS_OM = WS_QM + 16 * D * 2;
constexpr size_t WS_UM = WS_OM + 16 * D * 2;
constexpr size_t WS_SSQM = WS_UM + 16 * FF * 2;
constexpr size_t WS_BAR = (WS_SSQM + 9 * 16 * 8 + 255) / 256 * 256;
constexpr size_t WS_END = WS_BAR + 256;

struct Params {
    const float *x, *meta, *norm_attn, *norm_mlp, *w_up, *w_down, *fox_w_in, *fox_b_f, *fox_w_o, *kv_norm, *w_kv, *sb_w_q, *sb_w_o, *final_norm;
    float* out; unsigned char* ws;
};

DI unsigned f2bf(float f) { unsigned u = __float_as_uint(f); u += 0x7FFFu + ((u >> 16) & 1u); return u >> 16; }
typedef float f32x2_t __attribute__((ext_vector_type(2)));
typedef __bf16 bf16x2_t __attribute__((ext_vector_type(2)));
DI unsigned pk2(float lo, float hi) { f32x2_t v = {lo, hi}; return __builtin_bit_cast(unsigned, __builtin_convertvector(v, bf16x2_t)); }
DI float bf2f(unsigned short b) { return __uint_as_float(((unsigned)b) << 16); }
DI float bflo(unsigned w) { return __uint_as_float(w << 16); }
DI float bfhi(unsigned w) { return __uint_as_float(w & 0xFFFF0000u); }
DI float ex2(float x) { return __builtin_amdgcn_exp2f(x); }
DI float lg2(float x) { return __builtin_amdgcn_logf(x); }
typedef unsigned long long u64;
constexpr float SSQ_SCALE = 16777216.0f;
DI float rstd_of(u64 ssq) { return __builtin_amdgcn_rsqf((float)ssq * (1.0f / (SSQ_SCALE * D)) + EPS); }
DI u64 ssq_fix(float s) { return (u64)(s * SSQ_SCALE + 0.5f); }
DI int prow_of(int tok) { return (tok >> 11) * LP + ROFF + (tok & 2047); }
DI float wave_sum(float v) {
#pragma unroll
    for (int o = 1; o < 64; o <<= 1) v += __shfl_xor(v, o);
    return v;
}
DI float wave_max(float v) {
#pragma unroll
    for (int o = 1; o < 64; o <<= 1) v = fmaxf(v, __shfl_xor(v, o));
    return v;
}
DI size_t opaque0() { size_t z = 0; asm volatile("" : "+s"(z)); return z; }
DI float xor32(float x, int lane) {
    const unsigned u = __float_as_uint(x); const auto r = __builtin_amdgcn_permlane32_swap(u, u, false, false);
    return __uint_as_float((lane & 32) ? r[0] : r[1]); }
DI void lds_fence() { asm volatile("s_waitcnt lgkmcnt(0)" ::: "memory"); __builtin_amdgcn_wave_barrier(); }

DI void grid_bar(unsigned* cnt, unsigned target) {
    asm volatile("s_waitcnt vmcnt(0) lgkmcnt(0)" ::: "memory");
    __syncthreads();
    if (threadIdx.x == 0) {
        __builtin_amdgcn_fence(__ATOMIC_RELEASE, "agent");
        __hip_atomic_fetch_add(cnt, 1u, __ATOMIC_RELAXED, __HIP_MEMORY_SCOPE_AGENT);
        while (__hip_atomic_load(cnt, __ATOMIC_RELAXED, __HIP_MEMORY_SCOPE_AGENT) < target) __builtin_amdgcn_s_sleep(2);
        __builtin_amdgcn_fence(__ATOMIC_ACQUIRE, "agent");
    }
    __syncthreads();
}

DI void grid_bar_x(unsigned* base, unsigned xcc, unsigned k) {
    asm volatile("s_waitcnt vmcnt(0) lgkmcnt(0)" ::: "memory");
    __syncthreads();
    if (threadIdx.x == 0) {
        const unsigned old = __hip_atomic_fetch_add(base + 16 + xcc, 1u, __ATOMIC_RELAXED, __HIP_MEMORY_SCOPE_AGENT);
        if (old + 1u == 32u * k) {
            __builtin_amdgcn_fence(__ATOMIC_RELEASE, "agent");
            __hip_atomic_fetch_add(base + 24, 1u, __ATOMIC_RELAXED, __HIP_MEMORY_SCOPE_AGENT);
        }
        while (__hip_atomic_load(base + 24, __ATOMIC_RELAXED, __HIP_MEMORY_SCOPE_AGENT) < 8u * k) { }
        __builtin_amdgcn_fence(__ATOMIC_ACQUIRE, "agent");
    }
    __syncthreads();
}

enum { E_QK = 0, E_VT = 1, E_FG = 2, E_RES = 3, E_UP = 4 };
struct EpiCtx {
    unsigned char* ws;
    const u64* ssq_in;  const u64* ssqm_in;
    u64* ssq_out; u64* ssqm_out;
    const float* hin; const float* hmin;
    const float* bfg;
    float rsc;
};

DI float epi_elem(const EpiCtx& e, int ek, bool meta, int row, int col, float v) {
    unsigned char* ws = e.ws;
    if (ek == E_QK) {
        const float val = v * rstd_of(meta ? e.ssqm_in[row] : e.ssq_in[row]);
        const bf16_t o = (bf16_t)f2bf(val);
        if (col < D) { bf16_t* q = (bf16_t*)(ws + (meta ? WS_QM : WS_QB)); q[(size_t)row * D + col] = o; }
        else {
            bf16_t* kb = (bf16_t*)(ws + WS_KB);
            if (meta) { for (int b = 0; b < NB; ++b) kb[((size_t)b * LP + MOFF + row) * D + (col - D)] = o; }
            else kb[(size_t)prow_of(row) * D + (col - D)] = o;
        }
        return 0.f;
    } else if (ek == E_VT) {
        const float val = v * rstd_of(meta ? e.ssqm_in[col] : e.ssq_in[col]);
        const bf16_t o = (bf16_t)f2bf(val);
        bf16_t* vt = (bf16_t*)(ws + WS_VT);
        if (meta) { for (int b = 0; b < NB; ++b) vt[(size_t)row * VLD + b * LP + MOFF + col] = o; }
        else vt[(size_t)row * VLD + prow_of(col)] = o;
        return 0.f;
    } else if (ek == E_FG) {
        const float xx = v * rstd_of(meta ? e.ssqm_in[col] : e.ssq_in[col]) + e.bfg[row];
        const float lf = fminf(xx, 0.f) - log1pf(expf(-fabsf(xx)));
        float* LF = (float*)(ws + WS_LF);
        if (meta) { for (int b = 0; b < NB; ++b) LF[((size_t)b * NH + row) * LP + MOFF + col] = lf; }
        else LF[((size_t)(col >> 11) * NH + row) * LP + ROFF + (col & 2047)] = lf;
        return 0.f;
    } else if (ek == E_RES) {
        bf16_t* hb = (bf16_t*)(ws + (meta ? WS_HBM : WS_HB));
        float base;
        if (meta) base = e.hmin[(size_t)row * D + col]; else base = e.hin ? e.hin[(size_t)row * D + col] : bf2f(hb[(size_t)row * D + col]);
        const float hn = base + v;
        if (meta) ((float*)(ws + WS_HM))[(size_t)row * D + col] = hn;
        hb[(size_t)row * D + col] = (bf16_t)f2bf(hn);
        return hn * hn;
    } else {
        float t = v * rstd_of(meta ? e.ssqm_in[row] : e.ssq_in[row]); t = fmaxf(t, 0.f); t = t * t;
        bf16_t* u = (bf16_t*)(ws + (meta ? WS_UM : WS_UB)); u[(size_t)row * FF + col] = (bf16_t)f2bf(t);
        return 0.f;
    }
}

enum { JK_NONE = 0, JK_META_IN, JK_FG, JK_FG_META, JK_META_RES, JK_META_UP, JK_NAIVE };
struct SkJob { const bf16_t* X; const bf16_t* Y; int K; int n; int kind; int colofs; int ek; int nNt; int yIsItemN; };

DI void skinny_items(const SkJob& jb, const EpiCtx& e_in, LAS unsigned char* lds, int G, int bid) {
    if (jb.kind == JK_NONE || jb.n <= 0) return;
    int tid = threadIdx.x; asm volatile("" : "+v"(tid));
    const int lane = tid & 63, w = __builtin_amdgcn_readfirstlane(tid >> 6);
    const int K = jb.K, kw = K >> 3;
    LAS f32x4* red = (LAS f32x4*)lds;
    for (int it = bid; it < jb.n; it += G) {
        EpiCtx e = e_in; e.ws = e_in.ws + opaque0();
        int xi = 0, yi = it;
        if (jb.kind == JK_NAIVE) { xi = it / jb.nNt; yi = it % jb.nNt; }
        else if (jb.kind == JK_FG_META) { yi = 0; }
        const bf16_t* xp = jb.X + ((size_t)xi * 16 + (lane & 15)) * K + w * kw + 8 * (lane >> 4);
        const bf16_t* yp = jb.Y + ((size_t)yi * 16 + (lane & 15)) * K + w * kw + 8 * (lane >> 4);
        f32x4 acc = {0.f, 0.f, 0.f, 0.f};
        for (int s = 0; s < kw; s += 256) {
            bf16x8 a[8], b[8];
#pragma unroll
            for (int i = 0; i < 8; ++i) { a[i] = *(const bf16x8*)(xp + s + 32 * i); b[i] = *(const bf16x8*)(yp + s + 32 * i); }
#pragma unroll
            for (int i = 0; i < 8; ++i) acc = __builtin_amdgcn_mfma_f32_16x16x32_bf16(a[i], b[i], acc, 0, 0, 0);
        }
        __syncthreads();
        red[w * 64 + lane] = acc;
        __syncthreads();
        if (w == 0) {
            f32x4 s = red[lane];
#pragma unroll
            for (int i = 1; i < 8; ++i) s += red[i * 64 + lane];
            const int j = lane & 15, i0 = 4 * (lane >> 4);
#pragma unroll
            for (int r = 0; r < 4; ++r) {
                const int i = i0 + r; const float v = s[r];
                float sq = 0.f; bool resm = false; int rrow = 0;
                switch (jb.kind) {
                    case JK_META_IN: { const int n = jb.colofs + it * 16 + j; if (n < 2 * D) epi_elem(e, E_QK, true, i, n, v); else epi_elem(e, E_VT, true, n - 2 * D, i, v); } break;
                    case JK_FG: epi_elem(e, E_FG, false, i, it * 16 + j, v); break;
                    case JK_FG_META: epi_elem(e, E_FG, true, i, j, v); break;
                    case JK_META_RES: sq = epi_elem(e, E_RES, true, i, it * 16 + j, v); resm = true; rrow = i; break;
                    case JK_META_UP: epi_elem(e, E_UP, true, i, it * 16 + j, v); break;
                    default: {
                        const int row = xi * 16 + i, col = yi * 16 + j;
                        sq = epi_elem(e, jb.ek, false, row, col, v); rrow = row; } break;
                }
                if (jb.kind == JK_META_RES || (jb.kind == JK_NAIVE && jb.ek == E_RES)) {
                    sq += __shfl_xor(sq, 1); sq += __shfl_xor(sq, 2); sq += __shfl_xor(sq, 4); sq += __shfl_xor(sq, 8);
                    if (j == 0) __hip_atomic_fetch_add((resm ? e.ssqm_out : e.ssq_out) + rrow, ssq_fix(sq), __ATOMIC_RELAXED, __HIP_MEMORY_SCOPE_AGENT);
                }
            }
        }
    }
    __syncthreads();
}

namespace pg8 {
constexpr int BM = 256, BK = 64, HALF = 128, HTB = HALF * BK * 2, STAGE_BYTES = 8 * HTB, NXCD = 8, WGM = 4;
DI int lds_byte(int r, int c) { const int st = (r >> 4) * 2 + (c >> 5), rr = r & 15, cc = c & 31, ob = rr * 64 + cc * 2; return st * 1024 + (ob ^ (((ob >> 9) & 1) << 5)); }
DI void stage_rc(int b, int& R, int& C) { const int st = b / 1024, sb = b % 1024, swz = sb ^ (((sb >> 9) & 1) << 5); R = (st >> 1) * 16 + swz / 64; C = (st & 1) * 32 + (swz % 64) / 2; }
DI int perm32(int rho) { const int n = rho >> 4, i = rho & 15; return 8 * (i >> 2) + 4 * n + (i & 3); }

struct Unit { const char* a; const char* b; int pm, pn, ek; };
struct Sched {
    const bf16_t *A0, *B0, *A1, *B1; int nM0, nN0, ek0, nM1, nN1, ek1, K, G, c; int ablk;
    int pmmask;
    DI bool next(int i, Unit& u) const {
        int L = i * G + c; const int n0 = nM0 * nN0, n1 = nM1 * nN1;
        const bool second = L >= n0;
        if (second) { L -= n0; if (L >= n1) return false; }
        const bf16_t* A = second ? A1 : A0; const bf16_t* B = second ? B1 : B0;
        const int nM = second ? nM1 : nM0, nN = second ? nN1 : nN0, nwg = nM * nN;
        int wgid = L; { const int q = nwg / NXCD, r = nwg % NXCD, xcd = wgid % NXCD, off = wgid / NXCD; wgid = (xcd < r ? xcd * (q + 1) : r * (q + 1) + (xcd - r) * q) + off; }
        const int nig = WGM * nN, gid = wgid / nig, fm = gid * WGM, gsz = (nM - fm) < WGM ? (nM - fm) : WGM;
        u.pm = fm + ((wgid % nig) % gsz); u.pn = (wgid % nig) / gsz; u.ek = second ? ek1 : ek0;
        const size_t tstep = (size_t)BM * K * 2;
        u.a = (const char*)A + (size_t)(pmmask ? (u.pm & pmmask) : u.pm) * tstep; u.b = (const char*)B + (size_t)u.pn * tstep;
        return true;
    }
};

DI void epilogue(const f32x4 (&acc)[2][2][4][2], const Unit& u, const EpiCtx& e, int wr, int wc, int fr, int fq) {
    unsigned char* ws = e.ws + opaque0();
    const int row0 = u.pm * BM + wr * 64 + fr, col0 = u.pn * BM + wc * 32 + 8 * fq;
    if (u.ek == E_VT) {
        bf16_t* vt = (bf16_t*)(ws + WS_VT);
#pragma unroll
        for (int bj = 0; bj < 2; ++bj) {
            const int tok = col0 + bj * HALF;
            f32x4 r0, r1;
#pragma unroll
            for (int j = 0; j < 4; ++j) { r0[j] = rstd_of(e.ssq_in[tok + j]); r1[j] = rstd_of(e.ssq_in[tok + 4 + j]); }
            const int pc = prow_of(tok);
#pragma unroll
            for (int ai = 0; ai < 2; ++ai)
#pragma unroll
                for (int m = 0; m < 4; ++m) {
                    const int row = row0 + ai * HALF + m * 16;
                    const f32x4 v0 = acc[ai][bj][m][0] * r0, v1 = acc[ai][bj][m][1] * r1;
                    u32x4 w; w.x = pk2(v0[0], v0[1]); w.y = pk2(v0[2], v0[3]); w.z = pk2(v1[0], v1[1]); w.w = pk2(v1[2], v1[3]);
                    *(u32x4*)(vt + (size_t)row * VLD + pc) = w;
                }
        }
        return;
    }
    if (u.ek == E_RES) {
        bf16_t* hb = (bf16_t*)(ws + WS_HB);
#define RES_ROW(V0, V1) do { \
                    const f32x4 v0 = (V0) + acc[ai][bj][m][0] * e.rsc, v1 = (V1) + acc[ai][bj][m][1] * e.rsc; \
                    u32x4 w; w.x = pk2(v0[0], v0[1]); w.y = pk2(v0[2], v0[3]); w.z = pk2(v1[0], v1[1]); w.w = pk2(v1[2], v1[3]); \
                    *(u32x4*)(hb + off) = w; \
                    ss += (v0[0] * v0[0] + v0[1] * v0[1]) + (v0[2] * v0[2] + v0[3] * v0[3]) + (v1[0] * v1[0] + v1[1] * v1[1]) + (v1[2] * v1[2] + v1[3] * v1[3]); } while (0)
#define RES_STAT() do { ss += __shfl_xor(ss, 16); ss += __shfl_xor(ss, 32); \
                    if (fq == 0 && e.rsc != 0.f) __hip_atomic_fetch_add(e.ssq_out + row, ssq_fix(ss), __ATOMIC_RELAXED, __HIP_MEMORY_SCOPE_AGENT); } while (0)
        if (e.hin) {
#pragma unroll
            for (int ai = 0; ai < 2; ++ai) {
                f32x4 r[4][2][2];
#pragma unroll
                for (int m = 0; m < 4; ++m)
#pragma unroll
                    for (int bj = 0; bj < 2; ++bj) { const size_t off = (size_t)(row0 + ai * HALF + m * 16) * D + col0 + bj * HALF; r[m][bj][0] = *(const f32x4*)(e.hin + off); r[m][bj][1] = *(const f32x4*)(e.hin + off + 4); }
#pragma unroll
                for (int m = 0; m < 4; ++m) {
                    const int row = row0 + ai * HALF + m * 16; float ss = 0.f;
#pragma unroll
                    for (int bj = 0; bj < 2; ++bj) { const size_t off = (size_t)row * D + col0 + bj * HALF; RES_ROW(r[m][bj][0], r[m][bj][1]); }
                    RES_STAT();
                }
                asm volatile("" ::: "memory");
            }
        } else {
            u32x4 q[2][4][2];
#pragma unroll
            for (int ai = 0; ai < 2; ++ai)
#pragma unroll
                for (int m = 0; m < 4; ++m)
#pragma unroll
                    for (int bj = 0; bj < 2; ++bj) q[ai][m][bj] = *(const u32x4*)(hb + (size_t)(row0 + ai * HALF + m * 16) * D + col0 + bj * HALF);
#pragma unroll
            for (int ai = 0; ai < 2; ++ai)
#pragma unroll
                for (int m = 0; m < 4; ++m) {
                    const int row = row0 + ai * HALF + m * 16; float ss = 0.f;
#pragma unroll
                    for (int bj = 0; bj < 2; ++bj) {
                        const size_t off = (size_t)row * D + col0 + bj * HALF; const u32x4 t = q[ai][m][bj];
                        const f32x4 a0 = {bflo(t.x), bfhi(t.x), bflo(t.y), bfhi(t.y)}, a1 = {bflo(t.z), bfhi(t.z), bflo(t.w), bfhi(t.w)};
                        RES_ROW(a0, a1);
                    }
                    RES_STAT();
                }
        }
#undef RES_ROW
#undef RES_STAT
        return;
    }
#pragma unroll
    for (int ai = 0; ai < 2; ++ai)
#pragma unroll
        for (int m = 0; m < 4; ++m) {
            const int row = row0 + ai * HALF + m * 16;
            if (u.ek == E_QK) {
                const float rs = rstd_of(e.ssq_in[row]);
#pragma unroll
                for (int bj = 0; bj < 2; ++bj) {
                    const int col = col0 + bj * HALF;
                    const f32x4 v0 = acc[ai][bj][m][0] * rs, v1 = acc[ai][bj][m][1] * rs;
                    u32x4 w; w.x = pk2(v0[0], v0[1]); w.y = pk2(v0[2], v0[3]); w.z = pk2(v1[0], v1[1]); w.w = pk2(v1[2], v1[3]);
                    bf16_t* dst = (col < D) ? (bf16_t*)(ws + WS_QB) + (size_t)row * D + col : (bf16_t*)(ws + WS_KB) + (size_t)prow_of(row) * D + (col - D);
                    *(u32x4*)dst = w;
                }
            } else if (u.ek == E_UP) {
                const float rs = rstd_of(e.ssq_in[row]);
#pragma unroll
                for (int bj = 0; bj < 2; ++bj) {
                    const int col = col0 + bj * HALF;
                    f32x4 v0 = acc[ai][bj][m][0] * rs, v1 = acc[ai][bj][m][1] * rs;
#pragma unroll
                    for (int j = 0; j < 4; ++j) { v0[j] = fmaxf(v0[j], 0.f); v0[j] *= v0[j]; v1[j] = fmaxf(v1[j], 0.f); v1[j] *= v1[j]; }
                    u32x4 w; w.x = pk2(v0[0], v0[1]); w.y = pk2(v0[2], v0[3]); w.z = pk2(v1[0], v1[1]); w.w = pk2(v1[2], v1[3]);
                    *(u32x4*)((bf16_t*)(ws + WS_UB) + ((size_t)(row >> 8) * (FF / 64) + (col >> 6)) * 16384 + (row & 255) * 64 + (col & 63)) = w;
                }
            }
        }
}

DI void gemm_phase(LAS unsigned char* lds, const Sched& S, const EpiCtx& E) {
    int tid = threadIdx.x; asm volatile("" : "+v"(tid));
    const int wid = __builtin_amdgcn_readfirstlane(tid >> 6), lane = tid & 63, wr = wid >> 2, wc = wid & 3, fr = lane & 15, fq = lane >> 4;
    const int K = S.K, nt = K / BK;
    unsigned voffA[2], voffB[2];
#pragma unroll
    for (int i = 0; i < 2; ++i) { int R, C; stage_rc(tid * 16 + i * 8192, R, C); const int Rb = (R & ~31) + perm32(R & 31);
        voffA[i] = (unsigned)(R * (S.ablk ? BK : K) + C) * 2u; voffB[i] = (unsigned)(Rb * K + C) * 2u; }
    const size_t kstep = (size_t)(BK * 2);
    const size_t hstep = (size_t)HALF * K * 2;
    const size_t kstepA = S.ablk ? (size_t)BM * BK * 2 : kstep;
    const size_t hstepA = S.ablk ? (size_t)HALF * BK * 2 : hstep;
    const unsigned ldsw = (unsigned)wid * 1024u;
    const int aoff = lds_byte(wr * 64 + fr, fq * 8), boff = lds_byte(wc * 32 + fr, fq * 8);
#define PG8_SA(b, h) (((b) * 2 + (h)) * HTB)
#define PG8_SB(b, h) ((4 + (b) * 2 + (h)) * HTB)
#define PG8_STAGE(bufoff, gbase, voff) do { _Pragma("unroll") for (int _i = 0; _i < 2; ++_i) \
        __builtin_amdgcn_global_load_lds((const unsigned*)((const char*)(gbase) + (voff)[_i]), (LAS unsigned*)(lds + (bufoff) + ldsw + _i * 8192), 16, 0, 0); } while (0)
#define PG8_LDA(dst, b, h) do { _Pragma("unroll") for (int m = 0; m < 4; ++m) _Pragma("unroll") for (int k = 0; k < 2; ++k) dst[m][k] = *(const LAS bf16x8*)(lds + PG8_SA(b, h) + aoff + m * 2048 + k * 1024); } while (0)
#define PG8_LDB(dst, b, h) do { _Pragma("unroll") for (int n = 0; n < 2; ++n) _Pragma("unroll") for (int k = 0; k < 2; ++k) dst[n][k] = *(const LAS bf16x8*)(lds + PG8_SB(b, h) + boff + n * 2048 + k * 1024); } while (0)
#define PG8_MMA(ai, bj, At, Bt) do { __builtin_amdgcn_s_setprio(1); _Pragma("unroll") for (int m = 0; m < 4; ++m) _Pragma("unroll") for (int n = 0; n < 2; ++n) _Pragma("unroll") for (int k = 0; k < 2; ++k) \
        acc[ai][bj][m][n] = __builtin_amdgcn_mfma_f32_16x16x32_bf16(Bt[n][k], At[m][k], acc[ai][bj][m][n], 0, 0, 0); __builtin_amdgcn_s_setprio(0); } while (0)
#define PG8_WAIT_V(n) asm volatile("s_waitcnt vmcnt(" #n ")" ::: "memory")
#define PG8_WAIT_L(n) asm volatile("s_waitcnt lgkmcnt(" #n ")" ::: "memory")
#define PG8_BAR __builtin_amdgcn_s_barrier()
#define PG8_SCHED __builtin_amdgcn_sched_barrier(0)
    Unit cur, nxt; int ui = 0;
    if (!S.next(0, cur)) return;
    f32x4 acc[2][2][4][2];
#pragma unroll
    for (int a = 0; a < 2; ++a)
#pragma unroll
        for (int b = 0; b < 2; ++b)
#pragma unroll
            for (int m = 0; m < 4; ++m)
#pragma unroll
                for (int n = 0; n < 2; ++n) acc[a][b][m][n] = (f32x4){0.f, 0.f, 0.f, 0.f};
    bf16x8 At[4][2], B0[2][2], B1[2][2];
    const char* cA = cur.a; const char* cB = cur.b;
#if GEMM_SP2
    PG8_STAGE(PG8_SB(0, 0), cB, voffB); PG8_STAGE(PG8_SB(0, 1), cB + hstep, voffB); PG8_STAGE(PG8_SA(0, 0), cA, voffA); PG8_STAGE(PG8_SA(0, 1), cA + hstepA, voffA);
    if (wr == 1) PG8_BAR;
    PG8_WAIT_V(2); PG8_BAR;
    PG8_STAGE(PG8_SB(1, 0), cB + kstep, voffB); PG8_STAGE(PG8_SA(1, 0), cA + kstepA, voffA); PG8_STAGE(PG8_SB(1, 1), cB + hstep + kstep, voffB);
    PG8_WAIT_V(6); PG8_BAR;
#else
    PG8_STAGE(PG8_SB(0, 0), cB, voffB); PG8_STAGE(PG8_SA(0, 0), cA, voffA); PG8_STAGE(PG8_SB(0, 1), cB + hstep, voffB); PG8_STAGE(PG8_SA(0, 1), cA + hstepA, voffA);
    if (wr == 1) PG8_BAR;
    PG8_WAIT_V(4); PG8_BAR;
    PG8_STAGE(PG8_SB(1, 0), cB + kstep, voffB); PG8_STAGE(PG8_SA(1, 0), cA + kstepA, voffA); PG8_STAGE(PG8_SB(1, 1), cB + hstep + kstep, voffB);
    PG8_WAIT_V(6); PG8_BAR;
#endif
    for (;;) {
        const bool has_next = S.next(ui + 1, nxt);
        const char* nA = has_next ? nxt.a : cA; const char* nB = has_next ? nxt.b : cB;
        for (int t = 0; t < nt; t += 2) {
            const bool last = (t == nt - 2);
            const char* a1 = cA + (size_t)(t + 1) * kstepA;
            const char* a2 = last ? nA : cA + (size_t)(t + 2) * kstepA; const char* b2 = last ? nB : cB + (size_t)(t + 2) * kstep;
            const char* a3 = a2 + kstepA; const char* b3 = b2 + kstep;
#if GEMM_SP2
            PG8_LDB(B0, 0, 0); PG8_LDB(B1, 0, 1); PG8_SCHED; PG8_LDA(At, 0, 0); PG8_STAGE(PG8_SA(1, 1), a1 + hstepA, voffA);
            PG8_WAIT_V(8); PG8_WAIT_L(0); PG8_BAR; PG8_MMA(0, 0, At, B0); PG8_MMA(0, 1, At, B1); PG8_BAR; PG8_SCHED;
            PG8_LDA(At, 0, 1); PG8_STAGE(PG8_SB(0, 0), b2, voffB); PG8_STAGE(PG8_SB(0, 1), b2 + hstep, voffB); PG8_STAGE(PG8_SA(0, 0), a2, voffA);
            PG8_WAIT_V(8); PG8_WAIT_L(0); PG8_BAR; PG8_MMA(1, 0, At, B0); PG8_MMA(1, 1, At, B1); PG8_BAR; PG8_SCHED;
            PG8_LDB(B0, 1, 0); PG8_LDB(B1, 1, 1); PG8_SCHED; PG8_LDA(At, 1, 0); PG8_STAGE(PG8_SA(0, 1), a2 + hstepA, voffA);
            PG8_WAIT_V(8); PG8_WAIT_L(0); PG8_BAR; PG8_MMA(0, 0, At, B0); PG8_MMA(0, 1, At, B1); PG8_BAR; PG8_SCHED;
            PG8_LDA(At, 1, 1); PG8_STAGE(PG8_SB(1, 0), b3, voffB); PG8_STAGE(PG8_SB(1, 1), b3 + hstep, voffB); PG8_STAGE(PG8_SA(1, 0), a3, voffA);
            PG8_WAIT_V(8); PG8_WAIT_L(0); PG8_BAR; PG8_MMA(1, 0, At, B0); PG8_MMA(1, 1, At, B1); PG8_BAR; PG8_SCHED;
#else
            PG8_LDB(B0, 0, 0); PG8_SCHED; PG8_LDA(At, 0, 0); PG8_STAGE(PG8_SA(1, 1), a1 + hstepA, voffA);
            PG8_WAIT_L(8); PG8_BAR; PG8_WAIT_L(0); PG8_MMA(0, 0, At, B0); PG8_BAR; PG8_SCHED;
            PG8_LDB(B1, 0, 1); PG8_STAGE(PG8_SB(0, 0), b2, voffB);
            PG8_BAR; PG8_WAIT_L(0); PG8_MMA(0, 1, At, B1); PG8_BAR;
            PG8_LDA(At, 0, 1); PG8_STAGE(PG8_SA(0, 0), a2, voffA);
            PG8_BAR; PG8_WAIT_L(0); PG8_MMA(1, 0, At, B0); PG8_BAR; PG8_SCHED;
            PG8_STAGE(PG8_SB(0, 1), b2 + hstep, voffB);
            PG8_WAIT_V(6); PG8_BAR; PG8_MMA(1, 1, At, B1); PG8_BAR;
            PG8_LDB(B0, 1, 0); PG8_SCHED; PG8_LDA(At, 1, 0); PG8_STAGE(PG8_SA(0, 1), a2 + hstepA, voffA);
            PG8_WAIT_L(8); PG8_BAR; PG8_WAIT_L(0); PG8_MMA(0, 0, At, B0); PG8_BAR; PG8_SCHED;
            PG8_LDB(B1, 1, 1); PG8_STAGE(PG8_SB(1, 0), b3, voffB);
            PG8_BAR; PG8_WAIT_L(0); PG8_MMA(0, 1, At, B1); PG8_BAR;
            PG8_LDA(At, 1, 1); PG8_STAGE(PG8_SA(1, 0), a3, voffA);
            PG8_BAR; PG8_WAIT_L(0); PG8_MMA(1, 0, At, B0); PG8_BAR; PG8_SCHED;
            PG8_STAGE(PG8_SB(1, 1), b3 + hstep, voffB);
            PG8_WAIT_V(6); PG8_BAR; PG8_MMA(1, 1, At, B1); PG8_BAR;
        #endif
        }
#if GEMM_SP2
        if (wr == 0) PG8_BAR;
#endif
        epilogue(acc, cur, E, wr, wc, fr, fq);
        if (!has_next) break;
#pragma unroll
        for (int a = 0; a < 2; ++a)
#pragma unroll
            for (int b = 0; b < 2; ++b)
#pragma unroll
                for (int m = 0; m < 4; ++m)
#pragma unroll
                    for (int n = 0; n < 2; ++n) acc[a][b][m][n] = (f32x4){0.f, 0.f, 0.f, 0.f};
        cur = nxt; cA = nA; cB = nB; ++ui;
#if GEMM_SP2
        if (wr == 1) PG8_BAR;
#endif
    }
    PG8_WAIT_V(0);
#if !GEMM_SP2
    if (wr == 0) PG8_BAR;
#endif
    PG8_BAR;
#undef PG8_SA
#undef PG8_SB
#undef PG8_STAGE
#undef PG8_LDA
#undef PG8_LDB
#undef PG8_MMA
#undef PG8_WAIT_V
#undef PG8_WAIT_L
#undef PG8_BAR
#undef PG8_SCHED
}
}

struct CvJob { const float* src; int ld, K, N; bf16_t* dst; const float* g; int qs; };
constexpr int CT_IN = 16 * 96, CT_O = 16 * 32, CT_UP = 16 * 128, CT_DN = 64 * 32, CT_KV = 16 * 64;
constexpr int CT_TOTAL = 2 * CT_IN + 2 * CT_O + 4 * CT_UP + 4 * CT_DN + CT_O + CT_KV + CT_O + 2 * CT_O;
DI CvJob cv_job(const Params& P, int t, int& local) {
    unsigned char* ws = P.ws; CvJob j;
    if (t < 2 * CT_IN) { const int l = t / CT_IN; local = t % CT_IN; j = {P.fox_w_in + (size_t)l * D * NIN, NIN, D, 3 * D, (bf16_t*)(ws + WS_WT_IN) + (size_t)l * 3 * D * D, P.norm_attn + l * D, D}; return j; } t -= 2 * CT_IN;
    if (t < 2 * CT_O) { const int l = t / CT_O; local = t % CT_O; j = {P.fox_w_o + (size_t)l * D * D, D, D, D, (bf16_t*)(ws + WS_WT_O) + (size_t)l * D * D, nullptr, 0}; return j; } t -= 2 * CT_O;
    if (t < 4 * CT_UP) { const int l = t / CT_UP; local = t % CT_UP; j = {P.w_up + (size_t)l * D * FF, FF, D, FF, (bf16_t*)(ws + WS_WT_UP) + (size_t)l * FF * D, P.norm_mlp + l * D, 0}; return j; } t -= 4 * CT_UP;
    if (t < 4 * CT_DN) { const int l = t / CT_DN; local = t % CT_DN; j = {P.w_down + (size_t)l * FF * D, D, FF, D, (bf16_t*)(ws + WS_WT_DN) + (size_t)l * D * FF, nullptr, 0}; return j; } t -= 4 * CT_DN;
    if (t < CT_O) { local = t; j = {P.sb_w_q, D, D, D, (bf16_t*)(ws + WS_WT_QKV2), P.norm_attn + 2 * D, D}; return j; } t -= CT_O;
    if (t < CT_KV) { local = t; j = {P.w_kv, 2 * D, D, 2 * D, (bf16_t*)(ws + WS_WT_QKV2) + (size_t)D * D, P.kv_norm, 0}; return j; } t -= CT_KV;
    if (t < CT_O) { local = t; j = {P.sb_w_q + (size_t)D * D, D, D, D, (bf16_t*)(ws + WS_WT_Q3), P.norm_attn + 3 * D, D}; return j; } t -= CT_O;
    { const int l = t / CT_O; local = t % CT_O; j = {P.sb_w_o + (size_t)l * D * D, D, D, D, (bf16_t*)(ws + WS_WT_SO) + (size_t)l * D * D, nullptr, 0}; return j; }
}

DI void phase0(const Params& P, LAS unsigned char* lds, int G, int bid) {
    int tid = threadIdx.x; asm volatile("" : "+v"(tid));
    const int lane = tid & 63, w = tid >> 6;
    unsigned char* ws = P.ws;
    {
        u64* ssq = (u64*)(ws + WS_SSQ);
        for (int i = bid * NTHR + tid; i < 8 * MR; i += G * NTHR) ssq[MR + i] = 0ull;
        u64* ssqm = (u64*)(ws + WS_SSQM);
        if (bid == 0 && tid < 8 * 16) ssqm[16 + tid] = 0ull;
        u32x4 z = {0u, 0u, 0u, 0u};
        for (int i = bid * NTHR + tid; i < NB * 12288; i += G * NTHR) { const int b = i / 12288, r = i % 12288; *(u32x4*)(ws + WS_KB + (size_t)b * LP * D * 2 + (size_t)r * 16) = z; }
        for (int i = bid * NTHR + tid; i < D * NB * 6; i += G * NTHR) { const int d = i / (NB * 6), r = i % (NB * 6), b = r / 6, c = r % 6; *(u32x4*)(ws + WS_VT + ((size_t)d * VLD + b * LP) * 2 + c * 16) = z; }
    }
    {
        bf16_t* wf = (bf16_t*)(ws + WS_WF);
        for (int i = bid * NTHR + tid; i < 2 * 16 * D; i += G * NTHR) {
            const int l = i / (16 * D), r = i % (16 * D), k = r / 16, hd = r % 16;
            wf[(size_t)l * 16 * D + (size_t)hd * D + k] = (bf16_t)f2bf(P.norm_attn[l * D + k] * P.fox_w_in[(size_t)l * D * NIN + (size_t)k * NIN + 3 * D + hd]);
        }
    }
    {
        u64* ssq = (u64*)(ws + WS_SSQ); u64* ssqm = (u64*)(ws + WS_SSQM);
        for (int r = bid * 8 + w; r < MR + NMETA; r += G * 8) {
            const bool meta = r >= MR; const int rr = meta ? r - MR : r;
            const f32x4* src = (const f32x4*)((meta ? P.meta : P.x) + (size_t)rr * D) + lane;
            u32x2* dst = (u32x2*)(ws + (meta ? WS_HBM : WS_HB) + (size_t)rr * D * 2) + lane;
            float s = 0.f;
#pragma unroll
            for (int j = 0; j < 8; ++j) { const f32x4 v = src[64 * j]; s += (v[0] * v[0] + v[1] * v[1]) + (v[2] * v[2] + v[3] * v[3]); u32x2 o; o.x = pk2(v[0], v[1]); o.y = pk2(v[2], v[3]); dst[64 * j] = o; }
            s = wave_sum(s);
            if (lane == 0) { if (meta) ssqm[rr] = ssq_fix(s); else ssq[rr] = ssq_fix(s); }
        }
    }
    {
        LAS unsigned* T = (LAS unsigned*)lds;
        f32x4 ra[2][2], rb[2][2];
        bf16_t *da = nullptr, *db = nullptr; const float *ga = nullptr, *gb = nullptr; int Ka = 0, Kb = 0; bool sa = false, sb = false;
#define CV_LOAD(R, DST, GP, KD, SC, tt) do { int local_; const CvJob j_ = cv_job(P, (tt), local_); \
            const int nnt_ = j_.N / 64, k0_ = (local_ / nnt_) * 128, n0_ = (local_ % nnt_) * 64; \
            _Pragma("unroll") for (int p = 0; p < 2; ++p) { const int idx = tid + NTHR * p, kp = idx >> 4, nq = idx & 15; \
                const float* s_ = j_.src + (size_t)(k0_ + 2 * kp) * j_.ld + n0_ + 4 * nq; \
                R[p][0] = __builtin_nontemporal_load((const f32x4*)s_); R[p][1] = __builtin_nontemporal_load((const f32x4*)(s_ + j_.ld)); } \
            DST = j_.dst + (size_t)n0_ * j_.K + k0_; GP = j_.g ? j_.g + k0_ : nullptr; KD = j_.K; SC = n0_ < j_.qs; } while (0)
#define CV_CONVERT(R, GP, SC) do { _Pragma("unroll") for (int p = 0; p < 2; ++p) { const int idx = tid + NTHR * p, kp = idx >> 4, nq = idx & 15; \
                float g0 = 1.f, g1 = 1.f; if (GP) { g0 = GP[2 * kp]; g1 = GP[2 * kp + 1]; } \
                if (SC) { g0 *= QSCALE; g1 *= QSCALE; } \
                _Pragma("unroll") for (int i = 0; i < 4; ++i) T[(4 * nq + i) * 65 + kp] = pk2(R[p][0][i] * g0, R[p][1][i] * g1); } } while (0)
#define CV_STORE(DST, KD) do { _Pragma("unroll") for (int p = 0; p < 2; ++p) { const int idx = tid + NTHR * p, n = idx >> 4, kq = idx & 15; \
                u32x4 o; o.x = T[n * 65 + 4 * kq]; o.y = T[n * 65 + 4 * kq + 1]; o.z = T[n * 65 + 4 * kq + 2]; o.w = T[n * 65 + 4 * kq + 3]; \
                *(u32x4*)(DST + (size_t)n * KD + 8 * kq) = o; } } while (0)
        int t = bid;
        if (t < CT_TOTAL) CV_LOAD(ra, da, ga, Ka, sa, t);
        if (t + G < CT_TOTAL) CV_LOAD(rb, db, gb, Kb, sb, t + G);
        while (t < CT_TOTAL) {
            { bf16_t* cd = da; const int ck = Ka;
              CV_CONVERT(ra, ga, sa);
              if (t + 2 * G < CT_TOTAL) CV_LOAD(ra, da, ga, Ka, sa, t + 2 * G);
              __syncthreads();
              CV_STORE(cd, ck);
              __syncthreads(); }
            if (t + G >= CT_TOTAL) break;
            { bf16_t* cd = db; const int ck = Kb;
              CV_CONVERT(rb, gb, sb);
              if (t + 3 * G < CT_TOTAL) CV_LOAD(rb, db, gb, Kb, sb, t + 3 * G);
              __syncthreads();
              CV_STORE(cd, ck);
              __syncthreads(); }
            t += 2 * G;
        }
#undef CV_LOAD
#undef CV_CONVERT
#undef CV_STORE
    }
}

DI void compute_c2(const float* LF, int b, int h, LAS float* c2, LAS float* wtot) {
    int tid = threadIdx.x; asm volatile("" : "+v"(tid));
    const int lane = tid & 63, w = tid >> 6;
    const float* src = LF + ((size_t)b * NH + h) * LP;
    const int cbeg = w * 264, cend = cbeg + 264, p0 = cbeg + lane * 5;
    float v[5]; float run = 0.f;
#pragma unroll
    for (int e = 0; e < 5; ++e) { const int pos = p0 + e; const float x = (pos >= MOFF && pos < cend) ? src[pos] : 0.f; run += x; v[e] = run; }
    float incl = run;
#pragma unroll
    for (int o = 1; o < 64; o <<= 1) { const float t = __shfl_up(incl, o); if (lane >= o) incl += t; }
    const float excl = incl - run;
    if (lane == 63) wtot[w] = incl;
    __syncthreads();
    float wp = 0.f;
    for (int i = 0; i < w; ++i) wp += wtot[i];
#pragma unroll
    for (int e = 0; e < 5; ++e) { const int pos = p0 + e; if (pos < cend) c2[pos] = (pos < MOFF) ? __builtin_inff() : (wp + excl + v[e]) * LOG2E; }
    __syncthreads();
}

template <int TYPE>
DI void naive_attn_row(const unsigned char* ws, int b, int h, const bf16_t* qptr, int qpos, bf16_t* optr, const LAS float* c2, LAS float* sc, LAS float* qf) {
    int tid_ = threadIdx.x; asm volatile("" : "+v"(tid_));
    const int lane = tid_ & 63;
    const bf16_t* KB = (const bf16_t*)(ws + WS_KB); const bf16_t* VT = (const bf16_t*)(ws + WS_VT);
    { const unsigned qq = *(const unsigned*)(qptr + 2 * lane); qf[2 * lane] = bflo(qq); qf[2 * lane + 1] = bfhi(qq); }
    lds_fence();
    const int nkeys = (TYPE == 0) ? (qpos - MOFF + 1) : (qpos - MOFF);
    const int nk8 = (nkeys + 7) & ~7;
    for (int j = lane; j < nk8; j += 64) {
        float dot = 0.f;
        if (j < nkeys) {
            const u32x4* kp = (const u32x4*)(KB + ((size_t)b * LP + MOFF + j) * D + h * DH);
#pragma unroll 4
            for (int c = 0; c < 16; ++c) { const u32x4 kv = kp[c]; const f32x4 q0 = *(const LAS f32x4*)(qf + 8 * c), q1 = *(const LAS f32x4*)(qf + 8 * c + 4);
                dot += bflo(kv.x) * q0[0] + bfhi(kv.x) * q0[1] + bflo(kv.y) * q0[2] + bfhi(kv.y) * q0[3] + bflo(kv.z) * q1[0] + bfhi(kv.z) * q1[1] + bflo(kv.w) * q1[2] + bfhi(kv.w) * q1[3]; }
        }
        sc[j] = dot;
    }
    lds_fence();
    float inv = 1.f;
    if (TYPE == 0) {
        float m = -__builtin_inff();
        for (int j = lane; j < nkeys; j += 64) m = fmaxf(m, sc[j] - c2[MOFF + j]);
        m = wave_max(m);
        float l = 0.f;
        for (int j = lane; j < nk8; j += 64) { const float p = (j < nkeys) ? ex2(sc[j] - c2[MOFF + j] - m) : 0.f; l += p; sc[j] = p; }
        l = wave_sum(l); inv = 1.f / l;
    } else {
        float carry = 0.f;
        for (int top = nk8 - 1; top >= 0; top -= 64) {
            const int j = top - lane; const bool valid = (j >= 0) && (j < nkeys);
            const float y = (j >= 0) ? sc[j] : 0.f;
            const float sp = fmaxf(y, 0.f) + lg2(1.f + ex2(-fabsf(y)));
            const float lom = valid ? -sp : 0.f;
            float incl = lom;
#pragma unroll
            for (int o = 1; o < 64; o <<= 1) { const float t = __shfl_up(incl, o); if (lane >= o) incl += t; }
            const float a = valid ? ex2(y - sp + carry + (incl - lom)) : 0.f;
            if (j >= 0) sc[j] = a;
            carry += __shfl(incl, 63);
        }
    }
    lds_fence();
    float o0 = 0.f, o1 = 0.f;
    const bf16_t* v0 = VT + (size_t)(h * DH + 2 * lane) * VLD + b * LP + MOFF; const bf16_t* v1 = v0 + VLD;
#pragma unroll 2
    for (int j = 0; j < nk8; j += 8) {
        const u32x4 a = *(const u32x4*)(v0 + j), c = *(const u32x4*)(v1 + j);
        const f32x4 p0 = *(const LAS f32x4*)(sc + j), p1 = *(const LAS f32x4*)(sc + j + 4);
        o0 += bflo(a.x) * p0[0] + bfhi(a.x) * p0[1] + bflo(a.y) * p0[2] + bfhi(a.y) * p0[3] + bflo(a.z) * p1[0] + bfhi(a.z) * p1[1] + bflo(a.w) * p1[2] + bfhi(a.w) * p1[3];
        o1 += bflo(c.x) * p0[0] + bfhi(c.x) * p0[1] + bflo(c.y) * p0[2] + bfhi(c.y) * p0[3] + bflo(c.z) * p1[0] + bfhi(c.z) * p1[1] + bflo(c.w) * p1[2] + bfhi(c.w) * p1[3];
    }
    *(unsigned*)(optr + 2 * lane) = pk2(o0 * inv, o1 * inv);
    lds_fence();
}

constexpr int AT_C2 = 0, AT_WTOT = 8448, AT_K0 = 8704, AT_KSZ = 64 * 272, AT_V0 = AT_K0 + 2 * AT_KSZ, AT_VSZ = 128 * 144;
constexpr int NA_SC = 8704, NA_QF = NA_SC + 8 * 2064 * 4;
static_assert(AT_V0 + 3 * AT_VSZ <= 131072 && NA_QF + 8 * 128 * 4 <= 131072, "attention LDS");

DI int swap23(int m) { return (m & 0x13) | ((m & 4) << 1) | ((m & 8) >> 1); }

template <int TYPE>
DI void attn_item(const unsigned char* ws_in, LAS unsigned char* lds, int b, int h, int qb) {
    const unsigned char* ws = ws_in + opaque0();
    int tid = threadIdx.x; asm volatile("" : "+v"(tid));
    const int lane = tid & 63, w = __builtin_amdgcn_readfirstlane(tid >> 6), m32 = lane & 31, g = lane >> 5;
    const bf16_t* QB = (const bf16_t*)(ws + WS_QB); const bf16_t* KB = (const bf16_t*)(ws + WS_KB); const bf16_t* VT = (const bf16_t*)(ws + WS_VT);
    bf16_t* OB = (bf16_t*)(ws + WS_OB);
    const LAS float* c2 = (const LAS float*)(lds + AT_C2);
    const int nkt = 4 * qb + 5;
    const int prow0 = ROFF + 256 * qb + 32 * w, plast = prow0 + 31, qp = prow0 + m32;
    const int tok = b * SEQ + 256 * qb + 32 * w + m32;
    bf16x8 Q[8];
    { const bf16_t* qptr = QB + (size_t)tok * D + h * DH + 8 * g;
#pragma unroll
      for (int ks = 0; ks < 8; ++ks) Q[ks] = *(const bf16x8*)(qptr + 16 * ks); }
    f32x16 O[4];
#pragma unroll
    for (int i = 0; i < 4; ++i)
#pragma unroll
        for (int a = 0; a < 16; ++a) O[i][a] = 0.f;
    float mrun = -__builtin_inff(), lrun = 0.f, carry = 1.f;
    u32x4 kreg[2], vreg[2];
    const bf16_t* kbase = KB + (size_t)b * LP * D + h * DH;
    const bf16_t* vbase = VT + (size_t)h * DH * VLD + b * LP;
#define AT_LOAD(kt) do { _Pragma("unroll") for (int i = 0; i < 2; ++i) { const int ch = tid + NTHR * i; \
        kreg[i] = *(const u32x4*)(kbase + (size_t)(64 * (kt) + (ch >> 4)) * D + 8 * (ch & 15)); \
        vreg[i] = *(const u32x4*)(vbase + (size_t)(ch >> 3) * VLD + 64 * (kt) + 8 * (ch & 7)); } } while (0)
#define AT_STORE(kbuf, vbuf) do { _Pragma("unroll") for (int i = 0; i < 2; ++i) { const int ch = tid + NTHR * i; \
        *(LAS u32x4*)(lds + AT_K0 + (kbuf) * AT_KSZ + (ch >> 4) * 272 + (ch & 15) * 16) = kreg[i]; \
        *(LAS u32x4*)(lds + AT_V0 + (vbuf) * AT_VSZ + (ch >> 3) * 144 + (ch & 7) * 16) = vreg[i]; } } while (0)
#define AT_PV(vbuf) do { const LAS unsigned char* vb_ = lds + AT_V0 + (vbuf) * AT_VSZ; \
        _Pragma("unroll") for (int db = 0; db < 4; ++db) _Pragma("unroll") for (int blk = 0; blk < 2; ++blk) _Pragma("unroll") for (int s = 0; s < 2; ++s) { \
            const bf16x8 vf = *(const LAS bf16x8*)(vb_ + (32 * db + m32) * 144 + 64 * blk + 32 * s + 16 * g); \
            O[db] = __builtin_amdgcn_mfma_f32_32x32x16_bf16(vf, Pf[blk][s], O[db], 0, 0, 0); } } while (0)
    __syncthreads();
    if (TYPE == 1 && tid < 3) ((volatile LAS unsigned*)(lds + AT_WTOT))[tid] = 0u;
    { const int kt0 = (TYPE == 0) ? 0 : nkt - 1; AT_LOAD(kt0); AT_STORE(0, 0); }
    __syncthreads();
    const int krow = swap23(m32);
    const bool grpB = (w >= 4);
    bf16x8 Pf[2][2];
    bool pend = false; int vprev = 0, vcur = 0;
    volatile LAS unsigned* dcnt = (volatile LAS unsigned*)(lds + AT_WTOT);
    bool wdone = false; int dc = 0;
    for (int it = 0; it <= nkt; ++it) {
        if (TYPE == 1) {
            const int dn = (dc == 2) ? 0 : dc + 1, dz = (dn == 2) ? 0 : dn + 1;
            if (dcnt[dc] == 8u) { if (pend) { AT_PV(vprev); pend = false; } break; }
            if (tid == 0) dcnt[dz] = 0u;
            if (wdone && lane == 0) __hip_atomic_fetch_add((LAS unsigned*)(lds + AT_WTOT) + dn, 1u, __ATOMIC_RELAXED, __HIP_MEMORY_SCOPE_WORKGROUP);
            dc = dn;
        }
        const bool have = it < nkt;
        const int kt = (TYPE == 0) ? it : nkt - 1 - it, cur = it & 1;
        const bool more = it + 1 < nkt;
        const int vnext = (vcur == 2) ? 0 : vcur + 1;
        if (more) { const int ktn = (TYPE == 0) ? it + 1 : nkt - 2 - it; AT_LOAD(ktn); }
        if (pend) { AT_PV(vprev); pend = false; }
        if (have && 64 * kt <= plast && !wdone) {
            const LAS unsigned char* kb = lds + AT_K0 + cur * AT_KSZ;
            f32x16 S[2];
#pragma unroll
            for (int blk = 0; blk < 2; ++blk) {
                if (TYPE == 0) {
#pragma unroll
                    for (int s = 0; s < 2; ++s) { const int kp0 = 64 * kt + 32 * blk + 16 * s + 8 * g;
                        const f32x4 ca = *(const LAS f32x4*)(c2 + kp0), cb = *(const LAS f32x4*)(c2 + kp0 + 4);
#pragma unroll
                        for (int e = 0; e < 4; ++e) { S[blk][8 * s + e] = -ca[e]; S[blk][8 * s + 4 + e] = -cb[e]; } }
                } else {
#pragma unroll
                    for (int a = 0; a < 16; ++a) S[blk][a] = 0.f;
                }
#pragma unroll
                for (int ks = 0; ks < 8; ++ks) {
                    const bf16x8 kf = *(const LAS bf16x8*)(kb + (32 * blk + krow) * 272 + 32 * ks + 16 * g);
                    S[blk] = __builtin_amdgcn_mfma_f32_32x32x16_bf16(kf, Q[ks], S[blk], 0, 0, 0);
                }
            }
            const bool diag = (64 * kt + 63 >= prow0);
            if (TYPE == 0) {
                float mx = -__builtin_inff();
#define FOX_SCORE(MASKED) _Pragma("unroll") for (int blk = 0; blk < 2; ++blk) _Pragma("unroll") for (int s = 0; s < 2; ++s) { \
                        const int kp0 = 64 * kt + 32 * blk + 16 * s + 8 * g; \
                        _Pragma("unroll") for (int e = 0; e < 8; ++e) { \
                            float sv = S[blk][8 * s + e]; \
                            if (MASKED) { if (kp0 + e > qp) sv = -__builtin_inff(); } \
                            S[blk][8 * s + e] = sv; mx = fmaxf(mx, sv); } }
                if (diag) { FOX_SCORE(true) } else { FOX_SCORE(false) }
#undef FOX_SCORE
                mx = fmaxf(mx, xor32(mx, lane));
                const float mnew = fmaxf(mrun, mx);
                const float alpha = ex2(mrun - mnew);
                mrun = mnew;
                float rs = 0.f;
#pragma unroll
                for (int blk = 0; blk < 2; ++blk)
#pragma unroll
                    for (int s = 0; s < 2; ++s) {
                        float p[8];
#pragma unroll
                        for (int e = 0; e < 8; ++e) { p[e] = ex2(S[blk][8 * s + e] - mnew); rs += p[e]; }
                        u32x4 pw; pw.x = pk2(p[0], p[1]); pw.y = pk2(p[2], p[3]); pw.z = pk2(p[4], p[5]); pw.w = pk2(p[6], p[7]);
                        Pf[blk][s] = __builtin_bit_cast(bf16x8, pw);
                    }
                lrun = lrun * alpha + rs;
                if (__builtin_amdgcn_ballot_w64(alpha != 1.0f) != 0ull) {
#pragma unroll
                    for (int i = 0; i < 4; ++i)
#pragma unroll
                        for (int a = 0; a < 16; ++a) O[i][a] *= alpha;
                }
            } else {
                float T[2][2];
                const unsigned qlim = (unsigned)(qp - MOFF);
                const bool msk = diag || kt == 0;
#pragma unroll
                for (int blk = 0; blk < 2; ++blk)
#pragma unroll
                    for (int s = 0; s < 2; ++s) {
                        const int kp0 = 64 * kt + 32 * blk + 16 * s + 8 * g;
                        float run = 1.f;
#pragma unroll
                        for (int e = 7; e >= 0; --e) {
                            float y = S[blk][8 * s + e];
                            if (msk) y = ((unsigned)(kp0 + e - MOFF) < qlim) ? y : -126.f;
                            const float t = ex2(-fmaxf(y, -126.f));
                            const float beta = __builtin_amdgcn_rcpf(1.f + t), omb = t * beta;
                            S[blk][8 * s + e] = beta * run; run *= omb;
                        }
                        T[blk][s] = run;
                    }
                float PT[2][2];
#pragma unroll
                for (int blk = 0; blk < 2; ++blk)
#pragma unroll
                    for (int s = 0; s < 2; ++s) PT[blk][s] = xor32(T[blk][s], lane);
                float off[2][2]; float accu = carry;
#pragma unroll
                for (int blk = 1; blk >= 0; --blk)
#pragma unroll
                    for (int s = 1; s >= 0; --s) { off[blk][s] = (g == 0) ? accu * PT[blk][s] : accu; accu *= T[blk][s] * PT[blk][s]; }
                carry = accu;
                if (__builtin_amdgcn_ballot_w64(carry >= 7.888609e-31f) == 0ull) { wdone = true;
                    if (lane == 0) __hip_atomic_fetch_add((LAS unsigned*)(lds + AT_WTOT) + dc, 1u, __ATOMIC_RELAXED, __HIP_MEMORY_SCOPE_WORKGROUP); }
#pragma unroll
                for (int blk = 0; blk < 2; ++blk)
#pragma unroll
                    for (int s = 0; s < 2; ++s) {
                        float p[8];
#pragma unroll
                        for (int e = 0; e < 8; ++e) p[e] = S[blk][8 * s + e] * off[blk][s];
                        u32x4 pw; pw.x = pk2(p[0], p[1]); pw.y = pk2(p[2], p[3]); pw.z = pk2(p[4], p[5]); pw.w = pk2(p[6], p[7]);
                        Pf[blk][s] = __builtin_bit_cast(bf16x8, pw);
                    }
            }
            if (grpB) { pend = true; vprev = vcur; } else { AT_PV(vcur); }
        }
        if (more) AT_STORE(cur ^ 1, vnext);
        __syncthreads();
        vcur = vnext;
    }
#undef AT_LOAD
#undef AT_STORE
#undef AT_PV
    float inv = 1.f;
    if (TYPE == 0) { const float lt = lrun + xor32(lrun, lane); inv = 1.f / lt; }
    bf16_t* op = OB + (size_t)tok * D + h * DH + 4 * g;
#pragma unroll
    for (int db = 0; db < 4; ++db)
#pragma unroll
        for (int i = 0; i < 4; ++i) {
            u32x2 o; o.x = pk2(O[db][4 * i] * inv, O[db][4 * i + 1] * inv); o.y = pk2(O[db][4 * i + 2] * inv, O[db][4 * i + 3] * inv);
            *(u32x2*)(op + 32 * db + 8 * i) = o;
        }
}

DI void attn_phase(const Params& P, LAS unsigned char* lds, int layer, int G, int bid, int vcu) {
    int tid = threadIdx.x; asm volatile("" : "+v"(tid));
    const int w = tid >> 6;
    const unsigned char* ws = P.ws + opaque0();
    const float* LF = (const float*)(ws + WS_LF);
    LAS float* c2 = (LAS float*)(lds + AT_C2); LAS float* wtot = (LAS float*)(lds + AT_WTOT);
    LAS float* sc = (LAS float*)(lds + NA_SC) + w * 2064; LAS float* qf = (LAS float*)(lds + NA_QF) + w * 128;
    const bool fox = layer < 2;
    if (fox) {
        for (int it = bid; it < 32; it += G) {
            const int h = it >> 1, r = (it & 1) * 8 + w;
            compute_c2(LF, 0, h, c2, wtot);
            naive_attn_row<0>(ws, 0, h, (const bf16_t*)(ws + WS_QM) + (size_t)r * D + h * DH, MOFF + r, (bf16_t*)(P.ws + WS_OM) + (size_t)r * D + h * DH, c2, sc, qf);
            __syncthreads();
        }
    }
    const bool naive = fox ? (NAIVE_FOX != 0) : (NAIVE_SB != 0);
    if (naive) {
        for (int it = bid; it < NB * NH * 256; it += G) {
            const int bh = it >> 8, b = bh >> 4, h = bh & 15, t = (it & 255) * 8 + w;
            if (fox) compute_c2(LF, b, h, c2, wtot);
            const bf16_t* qptr = (const bf16_t*)(ws + WS_QB) + (size_t)(b * SEQ + t) * D + h * DH; bf16_t* optr = (bf16_t*)(P.ws + WS_OB) + (size_t)(b * SEQ + t) * D + h * DH;
            if (fox) naive_attn_row<0>(ws, b, h, qptr, ROFF + t, optr, c2, sc, qf); else naive_attn_row<1>(ws, b, h, qptr, ROFF + t, optr, c2, sc, qf);
            __syncthreads();
        }
    } else {
        for (int it = vcu; it < NB * NH * 4; it += G) {
            const int bh = it >> 2, b = bh >> 4, h = bh & 15, p = it & 3;
            if (fox) { __syncthreads(); compute_c2(LF, b, h, c2, wtot);
#pragma nounroll
                for (int hf = 0; hf < 2; ++hf) attn_item<0>(ws, lds, b, h, hf ? p : 7 - p); }
            else {
#pragma nounroll
                for (int hf = 0; hf < 2; ++hf) attn_item<1>(ws, lds, b, h, hf ? p : 7 - p); }
        }
    }
    __syncthreads();
}

DI EpiCtx make_epi(const Params& P, unsigned char* ws, int l, int kind) {
    u64* ssq = (u64*)(ws + WS_SSQ); u64* ssqm = (u64*)(ws + WS_SSQM);
    EpiCtx e{}; e.ws = ws; e.bfg = P.fox_b_f + (l < 2 ? l : 0) * NH; e.rsc = 1.f;
    e.ssq_in = ssq; e.ssqm_in = ssqm; e.ssq_out = ssq; e.ssqm_out = ssqm; e.hin = nullptr; e.hmin = (const float*)(ws + WS_HM);
    if (kind == 0) { e.ssq_in = ssq + (size_t)(2 * l) * MR; e.ssqm_in = ssqm + (2 * l) * 16; }
    else if (kind == 2) { if (l == 0) { e.hmin = P.meta; }     e.ssq_out = ssq + (size_t)(2 * l + 1) * MR; e.ssqm_out = ssqm + (2 * l + 1) * 16; }
    else if (kind == 3) { e.ssq_in = ssq + (size_t)(2 * l + 1) * MR; e.ssqm_in = ssqm + (2 * l + 1) * 16; }
    else { e.ssq_out = ssq + (size_t)(2 * l + 2) * MR; e.ssqm_out = ssqm + (2 * l + 2) * 16; }
    return e;
}
DI const bf16_t* phase_w(unsigned char* ws, int l, int kind) {
    if (kind == 0) return (l < 2) ? (const bf16_t*)(ws + WS_WT_IN) + (size_t)l * 3 * D * D : (l == 2 ? (const bf16_t*)(ws + WS_WT_QKV2) : (const bf16_t*)(ws + WS_WT_Q3));
    if (kind == 2) return (l < 2) ? (const bf16_t*)(ws + WS_WT_O) + (size_t)l * D * D : (const bf16_t*)(ws + WS_WT_SO) + (size_t)(l - 2) * D * D;
    if (kind == 3) return (const bf16_t*)(ws + WS_WT_UP) + (size_t)l * FF * D;
    return (const bf16_t*)(ws + WS_WT_DN) + (size_t)l * D * FF;
}
DI pg8::Sched make_sched(unsigned char* ws, int l, int kind, int G, int bid) {
    pg8::Sched S{}; S.G = G; S.c = bid; S.K = (kind == 4) ? FF : D;
    const bf16_t* W = phase_w(ws, l, kind); const bf16_t* HB = (const bf16_t*)(ws + WS_HB);
    S.A0 = HB; S.B0 = W; S.nM0 = 32; S.nN0 = 8; S.ek0 = E_RES; S.A1 = W; S.B1 = HB; S.nM1 = 0; S.nN1 = 0; S.ek1 = E_VT;
    if (kind == 0) { S.nN0 = (l < 3) ? 16 : 8; S.ek0 = E_QK; if (l < 3) { S.A1 = W + (size_t)2 * D * D; S.nM1 = 8; S.nN1 = 32; } }
    else if (kind == 2) { S.A0 = (const bf16_t*)(ws + WS_OB); }
    else if (kind == 3) { S.nN0 = 32; S.ek0 = E_UP; }
    else { S.A0 = (const bf16_t*)(ws + WS_UB); S.ablk = !NAIVE_GEMM; }
    return S;
}
DI SkJob make_job(unsigned char* ws, int l, int kind, int q) {
    SkJob j{}; j.kind = JK_NONE;
    const bf16_t* W = phase_w(ws, l, kind); const bf16_t* HB = (const bf16_t*)(ws + WS_HB); const bf16_t* HBM = (const bf16_t*)(ws + WS_HBM);
    if (q == 0) {
        if (kind == 0) { if (l < 2) j = {HBM, W, D, 384, JK_META_IN, 0, 0, 0, 0}; else if (l == 2) j = {HBM, W + (size_t)D * D, D, 256, JK_META_IN, D, 0, 0, 0}; }
        else if (l < 2) {
            if (kind == 2) j = {(const bf16_t*)(ws + WS_OM), W, D, 128, JK_META_RES, 0, 0, 0, 0};
            else if (kind == 3) j = {HBM, W, D, 512, JK_META_UP, 0, 0, 0, 0};
            else j = {(const bf16_t*)(ws + WS_UM), W, FF, 128, JK_META_RES, 0, 0, 0, 0};
        }
    } else if (q <= 2) {
        if (kind == 0 && l < 2) {
            const bf16_t* WF = (const bf16_t*)(ws + WS_WF) + (size_t)l * 16 * D;
            if (q == 1) j = {WF, HB, D, MR / 16, JK_FG, 0, 0, 0, 0}; else j = {WF, HBM, D, 1, JK_FG_META, 0, 0, 0, 0};
        }
    } else {
        const pg8::Sched S = make_sched(ws, l, kind, 1, 0);
        if (q == 3) j = {S.A0, S.B0, S.K, S.nM0 * 16 * S.nN0 * 16, JK_NAIVE, 0, S.ek0, S.nN0 * 16, 0};
        else j = {S.A1, S.B1, S.K, S.nM1 * 16 * S.nN1 * 16, JK_NAIVE, 0, S.ek1, S.nN1 * 16, 0};
    }
    return j;
}

__global__ void __launch_bounds__(NTHR, 2) yoco_mega(Params P) {
    extern __shared__ __attribute__((aligned(16))) unsigned char smem[];
    LAS unsigned char* lds = (LAS unsigned char*)smem;
    cg::grid_group grid = cg::this_grid();
    const int G = gridDim.x, bid = blockIdx.x;
    unsigned char* ws = P.ws;
    const unsigned xcc = (unsigned)__builtin_amdgcn_s_getreg((3 << 11) | 20) & 7u;
    {
        LAS unsigned* lw = (LAS unsigned*)(lds + LDS_BYTES - 16);
        if (threadIdx.x == 0) lw[0] = __hip_atomic_fetch_add((unsigned*)(ws + WS_BAR) + 8 + xcc, 1u, __ATOMIC_RELAXED, __HIP_MEMORY_SCOPE_AGENT);
        __syncthreads();
    }
    const unsigned xrank = __builtin_amdgcn_readfirstlane(((LAS unsigned*)(lds + LDS_BYTES - 16))[0]);
    phase0(P, lds, G, bid);
#if DUP_P0
    __syncthreads(); phase0(P, lds, G, bid);
#endif
    asm volatile("s_waitcnt vmcnt(0) lgkmcnt(0)" ::: "memory");
    grid.sync();
    unsigned* barcnt = (unsigned*)(ws + WS_BAR); unsigned nbar = 0;
    int vcu;
    bool xok; unsigned kx = 0;
    {
        bool ok = (G == 256);
        for (int i = 0; i < 8; ++i) ok = ok && (__hip_atomic_load((unsigned*)(ws + WS_BAR) + 8 + i, __ATOMIC_RELAXED, __HIP_MEMORY_SCOPE_AGENT) == 32u);
        vcu = ok ? (int)(xcc * 32u + xrank) : ((G % 8 == 0) ? (bid % 8) * (G / 8) + bid / 8 : bid);
        xok = ok;
    }
#define GBAR() do { if (xok) grid_bar_x(barcnt, xcc, ++kx); else grid_bar(barcnt, ++nbar * (unsigned)G); } while (0)
    const int vc = (G % 8 == 0) ? (vcu % (G / 8)) * 8 + vcu / (G / 8) : vcu;
#pragma nounroll
    for (int step0 = 0; step0 < 20 + DUP_STEP; ++step0) {
        const int step = (DUP_STEP && step0 > DUP_STEP_AT) ? step0 - 1 : step0;
        const int l = step / 5, kind = step % 5;
        if (kind == 1) { attn_phase(P, lds, l, G, bid, vcu);
#if DUP_FOX
            if (l == 0) attn_phase(P, lds, l, G, bid, vcu);
#endif
#if DUP_SB
            if (l == 2) attn_phase(P, lds, l, G, bid, vcu);
#endif
        }
        else {
#if !NAIVE_GEMM
            {
                unsigned char* wsl = P.ws + opaque0();
                const EpiCtx e = make_epi(P, wsl, l, kind);
                const pg8::Sched S = make_sched(wsl, l, kind, G, vc);
                pg8::gemm_phase(lds, S, e);
#if DUP_UP
                if (kind == 3 && l == 0) pg8::gemm_phase(lds, S, e);
#endif
#if DUP_RES
                if (kind == DUP_RES && l == 0) { GBAR(); EpiCtx e2 = e; e2.rsc = 0.f; e2.hin = nullptr; pg8::Sched S2 = S; S2.pmmask = DUP_PMMASK; pg8::gemm_phase(lds, S2, e2); }
#endif
            }
#endif
#pragma nounroll
            for (int q = 0; q < (NAIVE_GEMM ? 5 : 3); ++q) {
                unsigned char* wsl = P.ws + opaque0();
                const EpiCtx e = make_epi(P, wsl, l, kind);
                const SkJob jb = make_job(wsl, l, kind, q);
                skinny_items(jb, e, lds, G, bid);
            }
        }
        GBAR();
    }
#if DUP_BAR
    for (int i = 0; i < DUP_BAR; ++i) GBAR();
#endif
    {
        int tid = threadIdx.x; asm volatile("" : "+v"(tid));
        const int lane = tid & 63, w = tid >> 6;
        const u64* ssq = (const u64*)(ws + WS_SSQ) + (size_t)8 * MR; const bf16_t* hb = (const bf16_t*)(ws + WS_HB);
        for (int r = bid * 8 + w; r < MR; r += G * 8) {
            const float rs = rstd_of(ssq[r]);
            const u32x4* src = (const u32x4*)(hb + (size_t)r * D) + lane; const f32x4* gg = (const f32x4*)P.final_norm; f32x4* dst = (f32x4*)(P.out + (size_t)r * D);
#pragma unroll
            for (int j = 0; j < 4; ++j) {
                const u32x4 t = src[64 * j]; const int c4 = (lane + 64 * j) * 2;
                const f32x4 a0 = {bflo(t.x), bfhi(t.x), bflo(t.y), bfhi(t.y)}, a1 = {bflo(t.z), bfhi(t.z), bflo(t.w), bfhi(t.w)};
                dst[c4] = a0 * rs * gg[c4]; dst[c4 + 1] = a1 * rs * gg[c4 + 1];
            }
        }
    }
}

extern "C" void kernel_launch(void* const* d_in, const int* in_sizes, int n_in, void* d_out, int out_size, void* d_ws, size_t ws_size, hipStream_t stream) {
    static int grid = 0;
    if (grid == 0) {
        if (n_in != 14 || out_size != MR * D || ws_size < WS_END) { fprintf(stderr, "kernel_launch: unexpected shapes (n_in %d out %d ws %zu need %zu)\n", n_in, out_size, ws_size, (size_t)WS_END); grid = -1; return; }
        int dev = 0, cus = 0, per_cu = 0;
        hipGetDevice(&dev);
        hipDeviceGetAttribute(&cus, hipDeviceAttributeMultiprocessorCount, dev);
        if (hipFuncSetAttribute((const void*)yoco_mega, hipFuncAttributeMaxDynamicSharedMemorySize, LDS_BYTES) != hipSuccess) { fprintf(stderr, "kernel_launch: hipFuncSetAttribute failed\n"); grid = -1; return; }
        hipOccupancyMaxActiveBlocksPerMultiprocessor(&per_cu, (const void*)yoco_mega, NTHR, LDS_BYTES);
        (void)hipGetLastError();
        if (per_cu < 1) per_cu = 1;
        grid = cus * 1;
        fprintf(stderr, "kernel_launch: cus %d per_cu %d grid %d\n", cus, per_cu, grid);
    }
    if (grid < 0) return;
    Params p{};
    p.x = (const float*)d_in[0]; p.meta = (const float*)d_in[1]; p.norm_attn = (const float*)d_in[2]; p.norm_mlp = (const float*)d_in[3];
    p.w_up = (const float*)d_in[4]; p.w_down = (const float*)d_in[5]; p.fox_w_in = (const float*)d_in[6]; p.fox_b_f = (const float*)d_in[7];
    p.fox_w_o = (const float*)d_in[8]; p.kv_norm = (const float*)d_in[9]; p.w_kv = (const float*)d_in[10]; p.sb_w_q = (const float*)d_in[11];
    p.sb_w_o = (const float*)d_in[12]; p.final_norm = (const float*)d_in[13];
    p.out = (float*)d_out; p.ws = (unsigned char*)d_ws;
    if (hipMemsetAsync((unsigned char*)d_ws + WS_BAR, 0, 256, stream) != hipSuccess) { fprintf(stderr, "kernel_launch: memset failed\n"); return; }
    void* args[] = {&p};
    hipError_t e = hipLaunchCooperativeKernel((const void*)yoco_mega, dim3(grid), dim3(NTHR), args, LDS_BYTES, stream);
    if (e != hipSuccess) fprintf(stderr, "cooperative launch failed: %s (grid %d)\n", hipGetErrorString(e), grid);
}
```

```cpp
#include <hip/hip_runtime.h>
#include <hip/hip_cooperative_groups.h>
#include <cstdio>
#include <cstdint>
namespace cg = cooperative_groups;

#ifndef NAIVE_GEMM
#define NAIVE_GEMM 0
#endif
#ifndef NAIVE_FOX
#define NAIVE_FOX 0
#endif
#ifndef NAIVE_SB
#define NAIVE_SB 0
#endif

#ifndef GEMM_SP2
#define GEMM_SP2 1
#endif
#ifndef DUP_STEP
#define DUP_STEP 0
#endif
#ifndef DUP_STEP_AT
#define DUP_STEP_AT 3
#endif
#ifndef DUP_RES
#define DUP_RES 0
#endif
#ifndef DUP_PMMASK
#define DUP_PMMASK 0
#endif
#ifndef DUP_BAR
#define DUP_BAR 0
#endif
#ifndef DUP_P0
#define DUP_P0 0
#endif
#ifndef DUP_FOX
#define DUP_FOX 0
#endif
#ifndef DUP_SB
#define DUP_SB 0
#endif
#ifndef DUP_UP
#define DUP_UP 0
#endif
#define LAS __attribute__((address_space(3)))
#define DI __device__ __forceinline__
typedef unsigned short bf16_t;
typedef short bf16x8 __attribute__((ext_vector_type(8)));
typedef float f32x4 __attribute__((ext_vector_type(4)));
typedef float f32x16 __attribute__((ext_vector_type(16)));
typedef unsigned u32x4 __attribute__((ext_vector_type(4)));
typedef unsigned u32x2 __attribute__((ext_vector_type(2)));

constexpr int D = 2048, NB = 4, SEQ = 2048, NH = 16, DH = 128, FF = 8192, NMETA = 16;
constexpr int MR = NB * SEQ;
constexpr int LP = 2112;
constexpr int MOFF = 48, ROFF = 64;
constexpr int NIN = 3 * D + NH;
constexpr int VLD = NB * LP;
constexpr float EPS = 1e-6f;
constexpr float LOG2E = 1.4426950408889634f;
constexpr float QSCALE = 0.08838834764831845f * LOG2E;
constexpr int NTHR = 512;
constexpr int LDS_BYTES = 147456;

constexpr size_t SZ_DD = (size_t)D * D * 2;
constexpr size_t WS_WT_IN = 0;
constexpr size_t WS_WF = WS_WT_IN + 2 * 3 * SZ_DD;
constexpr size_t WS_WT_O = WS_WF + 2 * 16 * D * 2;
constexpr size_t WS_WT_UP = WS_WT_O + 2 * SZ_DD;
constexpr size_t WS_WT_DN = WS_WT_UP + 4 * 4 * SZ_DD;
constexpr size_t WS_WT_QKV2 = WS_WT_DN + 4 * 4 * SZ_DD;
constexpr size_t WS_WT_Q3 = WS_WT_QKV2 + 3 * SZ_DD;
constexpr size_t WS_WT_SO = WS_WT_Q3 + SZ_DD;
constexpr size_t WS_H = WS_WT_SO + 2 * SZ_DD;
constexpr size_t WS_HB = WS_H + (size_t)MR * D * 4;
constexpr size_t WS_QB = WS_HB + (size_t)MR * D * 2;
constexpr size_t WS_KB = WS_QB + (size_t)MR * D * 2;
constexpr size_t WS_VT = WS_KB + (size_t)NB * LP * D * 2;
constexpr size_t WS_OB = WS_VT + (size_t)D * VLD * 2;
constexpr size_t WS_UB = WS_OB + (size_t)MR * D * 2;
constexpr size_t WS_SSQ = WS_UB + (size_t)MR * FF * 2;
constexpr size_t WS_LF = WS_SSQ + 9 * (size_t)MR * 8;
constexpr size_t WS_HM = WS_LF + (size_t)NB * NH * LP * 4;
constexpr size_t WS_HBM = WS_HM + 16 * D * 4;
constexpr size_t WS_QM = WS_HBM + 16 * D * 2;
constexpr size_t WS_OM = WS_QM + 16 * D * 2;
constexpr size_t WS_UM = WS_OM + 16 * D * 2;
constexpr size_t WS_SSQM = WS_UM + 16 * FF * 2;
constexpr size_t WS_BAR = (WS_SSQM + 9 * 16 * 8 + 255) / 256 * 256;
constexpr size_t WS_END = WS_BAR + 256;

struct Params {
    const float *x, *meta, *norm_attn, *norm_mlp, *w_up, *w_down, *fox_w_in, *fox_b_f, *fox_w_o, *kv_norm, *w_kv, *sb_w_q, *sb_w_o, *final_norm;
    float* out; unsigned char* ws;
};

DI unsigned f2bf(float f) { unsigned u = __float_as_uint(f); u += 0x7FFFu + ((u >> 16) & 1u); return u >> 16; }
typedef float f32x2_t __attribute__((ext_vector_type(2)));
typedef __bf16 bf16x2_t __attribute__((ext_vector_type(2)));
DI unsigned pk2(float lo, float hi) { f32x2_t v = {lo, hi}; return __builtin_bit_cast(unsigned, __builtin_convertvector(v, bf16x2_t)); }
DI float bf2f(unsigned short b) { return __uint_as_float(((unsigned)b) << 16); }
DI float bflo(unsigned w) { return __uint_as_float(w << 16); }
DI float bfhi(unsigned w) { return __uint_as_float(w & 0xFFFF0000u); }
DI float ex2(float x) { return __builtin_amdgcn_exp2f(x); }
DI float lg2(float x) { return __builtin_amdgcn_logf(x); }
typedef unsigned long long u64;
constexpr float SSQ_SCALE = 16777216.0f;
DI float rstd_of(u64 ssq) { const float f = (float)(unsigned)(ssq >> 32) * 4294967296.0f + (float)(unsigned)ssq;
    return __builtin_amdgcn_rsqf(f * (1.0f / (SSQ_SCALE * D)) + EPS); }
DI u64 ssq_fix(float s) { return (u64)(s * SSQ_SCALE + 0.5f); }
DI int prow_of(int tok) { return (tok >> 11) * LP + ROFF + (tok & 2047); }
DI float wave_sum(float v) {
#pragma unroll
    for (int o = 1; o < 64; o <<= 1) v += __shfl_xor(v, o);
    return v;
}
DI float wave_max(float v) {
#pragma unroll
    for (int o = 1; o < 64; o <<= 1) v = fmaxf(v, __shfl_xor(v, o));
    return v;
}
DI size_t opaque0() { size_t z = 0; asm volatile("" : "+s"(z)); return z; }
DI float xor32(float x, int lane) {
    const unsigned u = __float_as_uint(x); const auto r = __builtin_amdgcn_permlane32_swap(u, u, false, false);
    return __uint_as_float((lane & 32) ? r[0] : r[1]); }
DI void lds_fence() { asm volatile("s_waitcnt lgkmcnt(0)" ::: "memory"); __builtin_amdgcn_wave_barrier(); }

DI void grid_bar(unsigned* cnt, unsigned target) {
    asm volatile("s_waitcnt vmcnt(0) lgkmcnt(0)" ::: "memory");
    __syncthreads();
    if (threadIdx.x == 0) {
        __builtin_amdgcn_fence(__ATOMIC_RELEASE, "agent");
        __hip_atomic_fetch_add(cnt, 1u, __ATOMIC_RELAXED, __HIP_MEMORY_SCOPE_AGENT);
        while (__hip_atomic_load(cnt, __ATOMIC_RELAXED, __HIP_MEMORY_SCOPE_AGENT) < target) __builtin_amdgcn_s_sleep(2);
        __builtin_amdgcn_fence(__ATOMIC_ACQUIRE, "agent");
    }
    __syncthreads();
}

DI void grid_bar_x(unsigned* base, unsigned xcc, unsigned k) {
    asm volatile("s_waitcnt vmcnt(0) lgkmcnt(0)" ::: "memory");
    __syncthreads();
    if (threadIdx.x == 0) {
        const unsigned old = __hip_atomic_fetch_add(base + 16 + xcc, 1u, __ATOMIC_RELAXED, __HIP_MEMORY_SCOPE_AGENT);
        if (old + 1u == 32u * k) {
            __builtin_amdgcn_fence(__ATOMIC_RELEASE, "agent");
            __hip_atomic_fetch_add(base + 24, 1u, __ATOMIC_RELAXED, __HIP_MEMORY_SCOPE_AGENT);
        }
        while (__hip_atomic_load(base + 24, __ATOMIC_RELAXED, __HIP_MEMORY_SCOPE_AGENT) < 8u * k) { }
        __builtin_amdgcn_fence(__ATOMIC_ACQUIRE, "agent");
    }
    __syncthreads();
}

enum { E_QK = 0, E_VT = 1, E_FG = 2, E_RES = 3, E_UP = 4 };
struct EpiCtx {
    unsigned char* ws;
    const u64* ssq_in;  const u64* ssqm_in;
    u64* ssq_out; u64* ssqm_out;
    const float* hin; const float* hmin;
    const float* bfg;
    float rsc;
};

DI float epi_elem(const EpiCtx& e, int ek, bool meta, int row, int col, float v) {
    unsigned char* ws = e.ws;
    if (ek == E_QK) {
        const float val = v * rstd_of(meta ? e.ssqm_in[row] : e.ssq_in[row]);
        const bf16_t o = (bf16_t)f2bf(val);
        if (col < D) { bf16_t* q = (bf16_t*)(ws + (meta ? WS_QM : WS_QB)); q[(size_t)row * D + col] = o; }
        else {
            bf16_t* kb = (bf16_t*)(ws + WS_KB);
            if (meta) { for (int b = 0; b < NB; ++b) kb[((size_t)b * LP + MOFF + row) * D + (col - D)] = o; }
            else kb[(size_t)prow_of(row) * D + (col - D)] = o;
        }
        return 0.f;
    } else if (ek == E_VT) {
        const float val = v * rstd_of(meta ? e.ssqm_in[col] : e.ssq_in[col]);
        const bf16_t o = (bf16_t)f2bf(val);
        bf16_t* vt = (bf16_t*)(ws + WS_VT);
        if (meta) { for (int b = 0; b < NB; ++b) vt[(size_t)row * VLD + b * LP + MOFF + col] = o; }
        else vt[(size_t)row * VLD + prow_of(col)] = o;
        return 0.f;
    } else if (ek == E_FG) {
        const float xx = v * rstd_of(meta ? e.ssqm_in[col] : e.ssq_in[col]) + e.bfg[row];
        const float lf = fminf(xx, 0.f) - log1pf(expf(-fabsf(xx)));
        float* LF = (float*)(ws + WS_LF);
        if (meta) { for (int b = 0; b < NB; ++b) LF[((size_t)b * NH + row) * LP + MOFF + col] = lf; }
        else LF[((size_t)(col >> 11) * NH + row) * LP + ROFF + (col & 2047)] = lf;
        return 0.f;
    } else if (ek == E_RES) {
        bf16_t* hb = (bf16_t*)(ws + (meta ? WS_HBM : WS_HB));
        float base;
        if (meta) base = e.hmin[(size_t)row * D + col]; else base = e.hin ? e.hin[(size_t)row * D + col] : bf2f(hb[(size_t)row * D + col]);
        const float hn = base + v;
        if (meta) ((float*)(ws + WS_HM))[(size_t)row * D + col] = hn;
        hb[(size_t)row * D + col] = (bf16_t)f2bf(hn);
        return hn * hn;
    } else {
        float t = v * rstd_of(meta ? e.ssqm_in[row] : e.ssq_in[row]); t = fmaxf(t, 0.f); t = t * t;
        bf16_t* u = (bf16_t*)(ws + (meta ? WS_UM : WS_UB)); u[(size_t)row * FF + col] = (bf16_t)f2bf(t);
        return 0.f;
    }
}

enum { JK_NONE = 0, JK_META_IN, JK_FG, JK_FG_META, JK_META_RES, JK_META_UP, JK_NAIVE };
struct SkJob { const bf16_t* X; const bf16_t* Y; int K; int n; int kind; int colofs; int ek; int nNt; int yIsItemN; };

DI void skinny_items(const SkJob& jb, const EpiCtx& e_in, LAS unsigned char* lds, int G, int bid) {
    if (jb.kind == JK_NONE || jb.n <= 0) return;
    int tid = threadIdx.x; asm volatile("" : "+v"(tid));
    const int lane = tid & 63, w = __builtin_amdgcn_readfirstlane(tid >> 6);
    const int K = jb.K, kw = K >> 3;
    LAS f32x4* red = (LAS f32x4*)lds;
    for (int it = bid; it < jb.n; it += G) {
        EpiCtx e = e_in; e.ws = e_in.ws + opaque0();
        int xi = 0, yi = it;
        if (jb.kind == JK_NAIVE) { xi = it / jb.nNt; yi = it % jb.nNt; }
        else if (jb.kind == JK_FG_META) { yi = 0; }
        const bf16_t* xp = jb.X + ((size_t)xi * 16 + (lane & 15)) * K + w * kw + 8 * (lane >> 4);
        const bf16_t* yp = jb.Y + ((size_t)yi * 16 + (lane & 15)) * K + w * kw + 8 * (lane >> 4);
        f32x4 acc = {0.f, 0.f, 0.f, 0.f};
        for (int s = 0; s < kw; s += 256) {
            bf16x8 a[8], b[8];
#pragma unroll
            for (int i = 0; i < 8; ++i) { a[i] = *(const bf16x8*)(xp + s + 32 * i); b[i] = *(const bf16x8*)(yp + s + 32 * i); }
#pragma unroll
            for (int i = 0; i < 8; ++i) acc = __builtin_amdgcn_mfma_f32_16x16x32_bf16(a[i], b[i], acc, 0, 0, 0);
        }
        __syncthreads();
        red[w * 64 + lane] = acc;
        __syncthreads();
        if (w == 0) {
            f32x4 s = red[lane];
#pragma unroll
            for (int i = 1; i < 8; ++i) s += red[i * 64 + lane];
            const int j = lane & 15, i0 = 4 * (lane >> 4);
#pragma unroll
            for (int r = 0; r < 4; ++r) {
                const int i = i0 + r; const float v = s[r];
                float sq = 0.f; bool resm = false; int rrow = 0;
                switch (jb.kind) {
                    case JK_META_IN: { const int n = jb.colofs + it * 16 + j; if (n < 2 * D) epi_elem(e, E_QK, true, i, n, v); else epi_elem(e, E_VT, true, n - 2 * D, i, v); } break;
                    case JK_FG: epi_elem(e, E_FG, false, i, it * 16 + j, v); break;
                    case JK_FG_META: epi_elem(e, E_FG, true, i, j, v); break;
                    case JK_META_RES: sq = epi_elem(e, E_RES, true, i, it * 16 + j, v); resm = true; rrow = i; break;
                    case JK_META_UP: epi_elem(e, E_UP, true, i, it * 16 + j, v); break;
                    default: {
                        const int row = xi * 16 + i, col = yi * 16 + j;
                        sq = epi_elem(e, jb.ek, false, row, col, v); rrow = row; } break;
                }
                if (jb.kind == JK_META_RES || (jb.kind == JK_NAIVE && jb.ek == E_RES)) {
                    sq += __shfl_xor(sq, 1); sq += __shfl_xor(sq, 2); sq += __shfl_xor(sq, 4); sq += __shfl_xor(sq, 8);
                    if (j == 0) __hip_atomic_fetch_add((resm ? e.ssqm_out : e.ssq_out) + rrow, ssq_fix(sq), __ATOMIC_RELAXED, __HIP_MEMORY_SCOPE_AGENT);
                }
            }
        }
    }
    __syncthreads();
}

namespace pg8 {
constexpr int BM = 256, BK = 64, HALF = 128, HTB = HALF * BK * 2, STAGE_BYTES = 8 * HTB, NXCD = 8, WGM = 4;
DI int lds_byte(int r, int c) { const int st = (r >> 4) * 2 + (c >> 5), rr = r & 15, cc = c & 31, ob = rr * 64 + cc * 2; return st * 1024 + (ob ^ (((ob >> 9) & 1) << 5)); }
DI void stage_rc(int b, int& R, int& C) { const int st = b / 1024, sb = b % 1024, swz = sb ^ (((sb >> 9) & 1) << 5); R = (st >> 1) * 16 + swz / 64; C = (st & 1) * 32 + (swz % 64) / 2; }
DI int perm32(int rho) { const int n = rho >> 4, i = rho & 15; return 8 * (i >> 2) + 4 * n + (i & 3); }

struct Unit { const char* a; const char* b; int pm, pn, ek; };
struct Sched {
    const bf16_t *A0, *B0, *A1, *B1; int nM0, nN0, ek0, nM1, nN1, ek1, K, G, c; int ablk;
    int pmmask;
    DI bool next(int i, Unit& u) const {
        int L = i * G + c; const int n0 = nM0 * nN0, n1 = nM1 * nN1;
        const bool second = L >= n0;
        if (second) { L -= n0; if (L >= n1) return false; }
        const bf16_t* A = second ? A1 : A0; const bf16_t* B = second ? B1 : B0;
        const int nM = second ? nM1 : nM0, nN = second ? nN1 : nN0, nwg = nM * nN;
        int wgid = L; { const int q = nwg / NXCD, r = nwg % NXCD, xcd = wgid % NXCD, off = wgid / NXCD; wgid = (xcd < r ? xcd * (q + 1) : r * (q + 1) + (xcd - r) * q) + off; }
        const int nig = WGM * nN, gid = wgid / nig, fm = gid * WGM, gsz = (nM - fm) < WGM ? (nM - fm) : WGM;
        u.pm = fm + ((wgid % nig) % gsz); u.pn = (wgid % nig) / gsz; u.ek = second ? ek1 : ek0;
        const size_t tstep = (size_t)BM * K * 2;
        u.a = (const char*)A + (size_t)(pmmask ? (u.pm & pmmask) : u.pm) * tstep; u.b = (const char*)B + (size_t)u.pn * tstep;
        return true;
    }
};

DI void epilogue(const f32x4 (&acc)[2][2][4][2], const Unit& u, const EpiCtx& e, int wr, int wc, int fr, int fq) {
    unsigned char* ws = e.ws + opaque0();
    const int row0 = u.pm * BM + wr * 64 + fr, col0 = u.pn * BM + wc * 32 + 8 * fq;
    if (u.ek == E_VT) {
        bf16_t* vt = (bf16_t*)(ws + WS_VT);
#pragma unroll
        for (int bj = 0; bj < 2; ++bj) {
            const int tok = col0 + bj * HALF;
            f32x4 r0, r1;
#pragma unroll
            for (int j = 0; j < 4; ++j) { r0[j] = rstd_of(e.ssq_in[tok + j]); r1[j] = rstd_of(e.ssq_in[tok + 4 + j]); }
            const int pc = prow_of(tok);
#pragma unroll
            for (int ai = 0; ai < 2; ++ai)
#pragma unroll
                for (int m = 0; m < 4; ++m) {
                    const int row = row0 + ai * HALF + m * 16;
                    const f32x4 v0 = acc[ai][bj][m][0] * r0, v1 = acc[ai][bj][m][1] * r1;
                    u32x4 w; w.x = pk2(v0[0], v0[1]); w.y = pk2(v0[2], v0[3]); w.z = pk2(v1[0], v1[1]); w.w = pk2(v1[2], v1[3]);
                    *(u32x4*)(vt + (size_t)row * VLD + pc) = w;
                }
        }
        return;
    }
    if (u.ek == E_RES) {
        bf16_t* hb = (bf16_t*)(ws + WS_HB);
#define RES_ROW(V0, V1) do { \
                    const f32x4 v0 = (V0) + acc[ai][bj][m][0] * e.rsc, v1 = (V1) + acc[ai][bj][m][1] * e.rsc; \
                    u32x4 w; w.x = pk2(v0[0], v0[1]); w.y = pk2(v0[2], v0[3]); w.z = pk2(v1[0], v1[1]); w.w = pk2(v1[2], v1[3]); \
                    *(u32x4*)(hb + off) = w; \
                    ss += (v0[0] * v0[0] + v0[1] * v0[1]) + (v0[2] * v0[2] + v0[3] * v0[3]) + (v1[0] * v1[0] + v1[1] * v1[1]) + (v1[2] * v1[2] + v1[3] * v1[3]); } while (0)
#define RES_STAT() do { ss += __shfl_xor(ss, 16); ss += __shfl_xor(ss, 32); \
                    if (fq == 0 && e.rsc != 0.f) __hip_atomic_fetch_add(e.ssq_out + row, ssq_fix(ss), __ATOMIC_RELAXED, __HIP_MEMORY_SCOPE_AGENT); } while (0)
        if (e.hin) {
#pragma unroll
            for (int ai = 0; ai < 2; ++ai) {
                f32x4 r[4][2][2];
#pragma unroll
                for (int m = 0; m < 4; ++m)
#pragma unroll
                    for (int bj = 0; bj < 2; ++bj) { const size_t off = (size_t)(row0 + ai * HALF + m * 16) * D + col0 + bj * HALF; r[m][bj][0] = *(const f32x4*)(e.hin + off); r[m][bj][1] = *(const f32x4*)(e.hin + off + 4); }
#pragma unroll
                for (int m = 0; m < 4; ++m) {
                    const int row = row0 + ai * HALF + m * 16; float ss = 0.f;
#pragma unroll
                    for (int bj = 0; bj < 2; ++bj) { const size_t off = (size_t)row * D + col0 + bj * HALF; RES_ROW(r[m][bj][0], r[m][bj][1]); }
                    RES_STAT();
                }
                asm volatile("" ::: "memory");
            }
        } else {
            u32x4 q[2][4][2];
#pragma unroll
            for (int ai = 0; ai < 2; ++ai)
#pragma unroll
                for (int m = 0; m < 4; ++m)
#pragma unroll
                    for (int bj = 0; bj < 2; ++bj) q[ai][m][bj] = *(const u32x4*)(hb + (size_t)(row0 + ai * HALF + m * 16) * D + col0 + bj * HALF);
#pragma unroll
            for (int ai = 0; ai < 2; ++ai)
#pragma unroll
                for (int m = 0; m < 4; ++m) {
                    const int row = row0 + ai * HALF + m * 16; float ss = 0.f;
#pragma unroll
                    for (int bj = 0; bj < 2; ++bj) {
                        const size_t off = (size_t)row * D + col0 + bj * HALF; const u32x4 t = q[ai][m][bj];
                        const f32x4 a0 = {bflo(t.x), bfhi(t.x), bflo(t.y), bfhi(t.y)}, a1 = {bflo(t.z), bfhi(t.z), bflo(t.w), bfhi(t.w)};
                        RES_ROW(a0, a1);
                    }
                    RES_STAT();
                }
        }
#undef RES_ROW
#undef RES_STAT
        return;
    }
#pragma unroll
    for (int ai = 0; ai < 2; ++ai)
#pragma unroll
        for (int m = 0; m < 4; ++m) {
            const int row = row0 + ai * HALF + m * 16;
            if (u.ek == E_QK) {
                const float rs = rstd_of(e.ssq_in[row]);
#pragma unroll
                for (int bj = 0; bj < 2; ++bj) {
                    const int col = col0 + bj * HALF;
                    const f32x4 v0 = acc[ai][bj][m][0] * rs, v1 = acc[ai][bj][m][1] * rs;
                    u32x4 w; w.x = pk2(v0[0], v0[1]); w.y = pk2(v0[2], v0[3]); w.z = pk2(v1[0], v1[1]); w.w = pk2(v1[2], v1[3]);
                    bf16_t* dst = (col < D) ? (bf16_t*)(ws + WS_QB) + (size_t)row * D + col : (bf16_t*)(ws + WS_KB) + (size_t)prow_of(row) * D + (col - D);
                    *(u32x4*)dst = w;
                }
            } else if (u.ek == E_UP) {
                const float rs = rstd_of(e.ssq_in[row]);
#pragma unroll
                for (int bj = 0; bj < 2; ++bj) {
                    const int col = col0 + bj * HALF;
                    f32x4 v0 = acc[ai][bj][m][0] * rs, v1 = acc[ai][bj][m][1] * rs;
#pragma unroll
                    for (int j = 0; j < 4; ++j) { v0[j] = fmaxf(v0[j], 0.f); v0[j] *= v0[j]; v1[j] = fmaxf(v1[j], 0.f); v1[j] *= v1[j]; }
                    u32x4 w; w.x = pk2(v0[0], v0[1]); w.y = pk2(v0[2], v0[3]); w.z = pk2(v1[0], v1[1]); w.w = pk2(v1[2], v1[3]);
                    *(u32x4*)((bf16_t*)(ws + WS_UB) + ((size_t)(row >> 8) * (FF / 64) + (col >> 6)) * 16384 + (row & 255) * 64 + (col & 63)) = w;
                }
            }
        }
}

DI void gemm_phase(LAS unsigned char* lds, const Sched& S, const EpiCtx& E) {
    int tid = threadIdx.x; asm volatile("" : "+v"(tid));
    const int wid = __builtin_amdgcn_readfirstlane(tid >> 6), lane = tid & 63, wr = wid >> 2, wc = wid & 3, fr = lane & 15, fq = lane >> 4;
    const int K = S.K, nt = K / BK;
    unsigned voffA[2], voffB[2];
#pragma unroll
    for (int i = 0; i < 2; ++i) { int R, C; stage_rc(tid * 16 + i * 8192, R, C); const int Rb = (R & ~31) + perm32(R & 31);
        voffA[i] = (unsigned)(R * (S.ablk ? BK : K) + C) * 2u; voffB[i] = (unsigned)(Rb * K + C) * 2u; }
    const size_t kstep = (size_t)(BK * 2);
    const size_t hstep = (size_t)HALF * K * 2;
    const size_t kstepA = S.ablk ? (size_t)BM * BK * 2 : kstep;
    const size_t hstepA = S.ablk ? (size_t)HALF * BK * 2 : hstep;
    const unsigned ldsw = (unsigned)wid * 1024u;
    const int aoff = lds_byte(wr * 64 + fr, fq * 8), boff = lds_byte(wc * 32 + fr, fq * 8);
#define PG8_SA(b, h) (((b) * 2 + (h)) * HTB)
#define PG8_SB(b, h) ((4 + (b) * 2 + (h)) * HTB)
#define PG8_STAGE(bufoff, gbase, voff) do { _Pragma("unroll") for (int _i = 0; _i < 2; ++_i) \
        __builtin_amdgcn_global_load_lds((const unsigned*)((const char*)(gbase) + (voff)[_i]), (LAS unsigned*)(lds + (bufoff) + ldsw + _i * 8192), 16, 0, 0); } while (0)
#define PG8_LDA(dst, b, h) do { _Pragma("unroll") for (int m = 0; m < 4; ++m) _Pragma("unroll") for (int k = 0; k < 2; ++k) dst[m][k] = *(const LAS bf16x8*)(lds + PG8_SA(b, h) + aoff + m * 2048 + k * 1024); } while (0)
#define PG8_LDB(dst, b, h) do { _Pragma("unroll") for (int n = 0; n < 2; ++n) _Pragma("unroll") for (int k = 0; k < 2; ++k) dst[n][k] = *(const LAS bf16x8*)(lds + PG8_SB(b, h) + boff + n * 2048 + k * 1024); } while (0)
#define PG8_MMA(ai, bj, At, Bt) do { __builtin_amdgcn_s_setprio(1); _Pragma("unroll") for (int m = 0; m < 4; ++m) _Pragma("unroll") for (int n = 0; n < 2; ++n) _Pragma("unroll") for (int k = 0; k < 2; ++k) \
        acc[ai][bj][m][n] = __builtin_amdgcn_mfma_f32_16x16x32_bf16(Bt[n][k], At[m][k], acc[ai][bj][m][n], 0, 0, 0); __builtin_amdgcn_s_setprio(0); } while (0)
#define PG8_WAIT_V(n) asm volatile("s_waitcnt vmcnt(" #n ")" ::: "memory")
#define PG8_WAIT_L(n) asm volatile("s_waitcnt lgkmcnt(" #n ")" ::: "memory")
#define PG8_BAR __builtin_amdgcn_s_barrier()
#define PG8_SCHED __builtin_amdgcn_sched_barrier(0)
    Unit cur, nxt; int ui = 0;
    if (!S.next(0, cur)) return;
    f32x4 acc[2][2][4][2];
#pragma unroll
    for (int a = 0; a < 2; ++a)
#pragma unroll
        for (int b = 0; b < 2; ++b)
#pragma unroll
            for (int m = 0; m < 4; ++m)
#pragma unroll
                for (int n = 0; n < 2; ++n) acc[a][b][m][n] = (f32x4){0.f, 0.f, 0.f, 0.f};
    bf16x8 At[4][2], B0[2][2], B1[2][2];
    const char* cA = cur.a; const char* cB = cur.b;
#if GEMM_SP2
    PG8_STAGE(PG8_SB(0, 0), cB, voffB); PG8_STAGE(PG8_SB(0, 1), cB + hstep, voffB); PG8_STAGE(PG8_SA(0, 0), cA, voffA); PG8_STAGE(PG8_SA(0, 1), cA + hstepA, voffA);
    if (wr == 1) PG8_BAR;
    PG8_WAIT_V(2); PG8_BAR;
    PG8_STAGE(PG8_SB(1, 0), cB + kstep, voffB); PG8_STAGE(PG8_SA(1, 0), cA + kstepA, voffA); PG8_STAGE(PG8_SB(1, 1), cB + hstep + kstep, voffB);
    PG8_WAIT_V(6); PG8_BAR;
#else
    PG8_STAGE(PG8_SB(0, 0), cB, voffB); PG8_STAGE(PG8_SA(0, 0), cA, voffA); PG8_STAGE(PG8_SB(0, 1), cB + hstep, voffB); PG8_STAGE(PG8_SA(0, 1), cA + hstepA, voffA);
    if (wr == 1) PG8_BAR;
    PG8_WAIT_V(4); PG8_BAR;
    PG8_STAGE(PG8_SB(1, 0), cB + kstep, voffB); PG8_STAGE(PG8_SA(1, 0), cA + kstepA, voffA); PG8_STAGE(PG8_SB(1, 1), cB + hstep + kstep, voffB);
    PG8_WAIT_V(6); PG8_BAR;
#endif
    for (;;) {
        const bool has_next = S.next(ui + 1, nxt);
        const char* nA = has_next ? nxt.a : cA; const char* nB = has_next ? nxt.b : cB;
        for (int t = 0; t < nt; t += 2) {
            const bool last = (t == nt - 2);
            const char* a1 = cA + (size_t)(t + 1) * kstepA;
            const char* a2 = last ? nA : cA + (size_t)(t + 2) * kstepA; const char* b2 = last ? nB : cB + (size_t)(t + 2) * kstep;
            const char* a3 = a2 + kstepA; const char* b3 = b2 + kstep;
#if GEMM_SP2
            PG8_LDB(B0, 0, 0); PG8_LDB(B1, 0, 1); PG8_SCHED; PG8_LDA(At, 0, 0); PG8_STAGE(PG8_SA(1, 1), a1 + hstepA, voffA);
            PG8_WAIT_V(8); PG8_WAIT_L(0); PG8_BAR; PG8_MMA(0, 0, At, B0); PG8_MMA(0, 1, At, B1); PG8_BAR; PG8_SCHED;
            PG8_LDA(At, 0, 1); PG8_STAGE(PG8_SB(0, 0), b2, voffB); PG8_STAGE(PG8_SB(0, 1), b2 + hstep, voffB); PG8_STAGE(PG8_SA(0, 0), a2, voffA);
            PG8_WAIT_V(8); PG8_WAIT_L(0); PG8_BAR; PG8_MMA(1, 0, At, B0); PG8_MMA(1, 1, At, B1); PG8_BAR; PG8_SCHED;
            PG8_LDB(B0, 1, 0); PG8_LDB(B1, 1, 1); PG8_SCHED; PG8_LDA(At, 1, 0); PG8_STAGE(PG8_SA(0, 1), a2 + hstepA, voffA);
            PG8_WAIT_V(8); PG8_WAIT_L(0); PG8_BAR; PG8_MMA(0, 0, At, B0); PG8_MMA(0, 1, At, B1); PG8_BAR; PG8_SCHED;
            PG8_LDA(At, 1, 1); PG8_STAGE(PG8_SB(1, 0), b3, voffB); PG8_STAGE(PG8_SB(1, 1), b3 + hstep, voffB); PG8_STAGE(PG8_SA(1, 0), a3, voffA);
            PG8_WAIT_V(8); PG8_WAIT_L(0); PG8_BAR; PG8_MMA(1, 0, At, B0); PG8_MMA(1, 1, At, B1); PG8_BAR; PG8_SCHED;
#else
            PG8_LDB(B0, 0, 0); PG8_SCHED; PG8_LDA(At, 0, 0); PG8_STAGE(PG8_SA(1, 1), a1 + hstepA, voffA);
            PG8_WAIT_L(8); PG8_BAR; PG8_WAIT_L(0); PG8_MMA(0, 0, At, B0); PG8_BAR; PG8_SCHED;
            PG8_LDB(B1, 0, 1); PG8_STAGE(PG8_SB(0, 0), b2, voffB);
            PG8_BAR; PG8_WAIT_L(0); PG8_MMA(0, 1, At, B1); PG8_BAR;
            PG8_LDA(At, 0, 1); PG8_STAGE(PG8_SA(0, 0), a2, voffA);
            PG8_BAR; PG8_WAIT_L(0); PG8_MMA(1, 0, At, B0); PG8_BAR; PG8_SCHED;
            PG8_STAGE(PG8_SB(0, 1), b2 + hstep, voffB);
            PG8_WAIT_V(6); PG8_BAR; PG8_MMA(1, 1, At, B1); PG8_BAR;
            PG8_LDB(B0, 1, 0); PG8_SCHED; PG8_LDA(At, 1, 0); PG8_STAGE(PG8_SA(0, 1), a2 + hstepA, voffA);
            PG8_WAIT_L(8); PG8_BAR; PG8_WAIT_L(0); PG8_MMA(0, 0, At, B0); PG8_BAR; PG8_SCHED;
            PG8_LDB(B1, 1, 1); PG8_STAGE(PG8_SB(1, 0), b3, voffB);
            PG8_BAR; PG8_WAIT_L(0); PG8_MMA(0, 1, At, B1); PG8_BAR;
            PG8_LDA(At, 1, 1); PG8_STAGE(PG8_SA(1, 0), a3, voffA);
            PG8_BAR; PG8_WAIT_L(0); PG8_MMA(1, 0, At, B0); PG8_BAR; PG8_SCHED;
            PG8_STAGE(PG8_SB(1, 1), b3 + hstep, voffB);
            PG8_WAIT_V(6); PG8_BAR; PG8_MMA(1, 1, At, B1); PG8_BAR;
        #endif
        }
#if GEMM_SP2
        if (wr == 0) PG8_BAR;
#endif
        epilogue(acc, cur, E, wr, wc, fr, fq);
        if (!has_next) break;
#pragma unroll
        for (int a = 0; a < 2; ++a)
#pragma unroll
            for (int b = 0; b < 2; ++b)
#pragma unroll
                for (int m = 0; m < 4; ++m)
#pragma unroll
                    for (int n = 0; n < 2; ++n) acc[a][b][m][n] = (f32x4){0.f, 0.f, 0.f, 0.f};
        cur = nxt; cA = nA; cB = nB; ++ui;
#if GEMM_SP2
        if (wr == 1) PG8_BAR;
#endif
    }
    PG8_WAIT_V(0);
#if !GEMM_SP2
    if (wr == 0) PG8_BAR;
#endif
    PG8_BAR;
#undef PG8_SA
#undef PG8_SB
#undef PG8_STAGE
#undef PG8_LDA
#undef PG8_LDB
#undef PG8_MMA
#undef PG8_WAIT_V
#undef PG8_WAIT_L
#undef PG8_BAR
#undef PG8_SCHED
}
}

struct CvJob { const float* src; int ld, K, N; bf16_t* dst; const float* g; int qs; };
constexpr int CT_IN = 16 * 96, CT_O = 16 * 32, CT_UP = 16 * 128, CT_DN = 64 * 32, CT_KV = 16 * 64;
constexpr int CT_TOTAL = 2 * CT_IN + 2 * CT_O + 4 * CT_UP + 4 * CT_DN + CT_O + CT_KV + CT_O + 2 * CT_O;
DI CvJob cv_job(const Params& P, int t, int& local) {
    unsigned char* ws = P.ws; CvJob j;
    if (t < 2 * CT_IN) { const int l = t / CT_IN; local = t % CT_IN; j = {P.fox_w_in + (size_t)l * D * NIN, NIN, D, 3 * D, (bf16_t*)(ws + WS_WT_IN) + (size_t)l * 3 * D * D, P.norm_attn + l * D, D}; return j; } t -= 2 * CT_IN;
    if (t < 2 * CT_O) { const int l = t / CT_O; local = t % CT_O; j = {P.fox_w_o + (size_t)l * D * D, D, D, D, (bf16_t*)(ws + WS_WT_O) + (size_t)l * D * D, nullptr, 0}; return j; } t -= 2 * CT_O;
    if (t < 4 * CT_UP) { const int l = t / CT_UP; local = t % CT_UP; j = {P.w_up + (size_t)l * D * FF, FF, D, FF, (bf16_t*)(ws + WS_WT_UP) + (size_t)l * FF * D, P.norm_mlp + l * D, 0}; return j; } t -= 4 * CT_UP;
    if (t < 4 * CT_DN) { const int l = t / CT_DN; local = t % CT_DN; j = {P.w_down + (size_t)l * FF * D, D, FF, D, (bf16_t*)(ws + WS_WT_DN) + (size_t)l * D * FF, nullptr, 0}; return j; } t -= 4 * CT_DN;
    if (t < CT_O) { local = t; j = {P.sb_w_q, D, D, D, (bf16_t*)(ws + WS_WT_QKV2), P.norm_attn + 2 * D, D}; return j; } t -= CT_O;
    if (t < CT_KV) { local = t; j = {P.w_kv, 2 * D, D, 2 * D, (bf16_t*)(ws + WS_WT_QKV2) + (size_t)D * D, P.kv_norm, 0}; return j; } t -= CT_KV;
    if (t < CT_O) { local = t; j = {P.sb_w_q + (size_t)D * D, D, D, D, (bf16_t*)(ws + WS_WT_Q3), P.norm_attn + 3 * D, D}; return j; } t -= CT_O;
    { const int l = t / CT_O; local = t % CT_O; j = {P.sb_w_o + (size_t)l * D * D, D, D, D, (bf16_t*)(ws + WS_WT_SO) + (size_t)l * D * D, nullptr, 0}; return j; }
}

DI void phase0(const Params& P, LAS unsigned char* lds, int G, int bid) {
    int tid = threadIdx.x; asm volatile("" : "+v"(tid));
    const int lane = tid & 63, w = tid >> 6;
    unsigned char* ws = P.ws;
    {
        u64* ssq = (u64*)(ws + WS_SSQ);
        for (int i = bid * NTHR + tid; i < 8 * MR; i += G * NTHR) ssq[MR + i] = 0ull;
        u64* ssqm = (u64*)(ws + WS_SSQM);
        if (bid == 0 && tid < 8 * 16) ssqm[16 + tid] = 0ull;
        u32x4 z = {0u, 0u, 0u, 0u};
        for (int i = bid * NTHR + tid; i < NB * 12288; i += G * NTHR) { const int b = i / 12288, r = i % 12288; *(u32x4*)(ws + WS_KB + (size_t)b * LP * D * 2 + (size_t)r * 16) = z; }
        for (int i = bid * NTHR + tid; i < D * NB * 6; i += G * NTHR) { const int d = i / (NB * 6), r = i % (NB * 6), b = r / 6, c = r % 6; *(u32x4*)(ws + WS_VT + ((size_t)d * VLD + b * LP) * 2 + c * 16) = z; }
    }
    {
        bf16_t* wf = (bf16_t*)(ws + WS_WF);
        for (int i = bid * NTHR + tid; i < 2 * 16 * D; i += G * NTHR) {
            const int l = i / (16 * D), r = i % (16 * D), k = r / 16, hd = r % 16;
            wf[(size_t)l * 16 * D + (size_t)hd * D + k] = (bf16_t)f2bf(P.norm_attn[l * D + k] * P.fox_w_in[(size_t)l * D * NIN + (size_t)k * NIN + 3 * D + hd]);
        }
    }
    {
        u64* ssq = (u64*)(ws + WS_SSQ); u64* ssqm = (u64*)(ws + WS_SSQM);
        for (int r = bid * 8 + w; r < MR + NMETA; r += G * 8) {
            const bool meta = r >= MR; const int rr = meta ? r - MR : r;
            const f32x4* src = (const f32x4*)((meta ? P.meta : P.x) + (size_t)rr * D) + lane;
            u32x2* dst = (u32x2*)(ws + (meta ? WS_HBM : WS_HB) + (size_t)rr * D * 2) + lane;
            float s = 0.f;
#pragma unroll
            for (int j = 0; j < 8; ++j) { const f32x4 v = src[64 * j]; s += (v[0] * v[0] + v[1] * v[1]) + (v[2] * v[2] + v[3] * v[3]); u32x2 o; o.x = pk2(v[0], v[1]); o.y = pk2(v[2], v[3]); dst[64 * j] = o; }
            s = wave_sum(s);
            if (lane == 0) { if (meta) ssqm[rr] = ssq_fix(s); else ssq[rr] = ssq_fix(s); }
        }
    }
    {
        LAS unsigned* T = (LAS unsigned*)lds;
        f32x4 ra[2][2], rb[2][2];
        bf16_t *da = nullptr, *db = nullptr; const float *ga = nullptr, *gb = nullptr; int Ka = 0, Kb = 0; bool sa = false, sb = false;
#define CV_LOAD(R, DST, GP, KD, SC, tt) do { int local_; const CvJob j_ = cv_job(P, (tt), local_); \
            const int nnt_ = j_.N / 64, k0_ = (local_ / nnt_) * 128, n0_ = (local_ % nnt_) * 64; \
            _Pragma("unroll") for (int p = 0; p < 2; ++p) { const int idx = tid + NTHR * p, kp = idx >> 4, nq = idx & 15; \
                const float* s_ = j_.src + (size_t)(k0_ + 2 * kp) * j_.ld + n0_ + 4 * nq; \
                R[p][0] = __builtin_nontemporal_load((const f32x4*)s_); R[p][1] = __builtin_nontemporal_load((const f32x4*)(s_ + j_.ld)); } \
            DST = j_.dst + (size_t)n0_ * j_.K + k0_; GP = j_.g ? j_.g + k0_ : nullptr; KD = j_.K; SC = n0_ < j_.qs; } while (0)
#define CV_CONVERT(R, GP, SC) do { _Pragma("unroll") for (int p = 0; p < 2; ++p) { const int idx = tid + NTHR * p, kp = idx >> 4, nq = idx & 15; \
                float g0 = 1.f, g1 = 1.f; if (GP) { g0 = GP[2 * kp]; g1 = GP[2 * kp + 1]; } \
                if (SC) { g0 *= QSCALE; g1 *= QSCALE; } \
                _Pragma("unroll") for (int i = 0; i < 4; ++i) T[(4 * nq + i) * 65 + kp] = pk2(R[p][0][i] * g0, R[p][1][i] * g1); } } while (0)
#define CV_STORE(DST, KD) do { _Pragma("unroll") for (int p = 0; p < 2; ++p) { const int idx = tid + NTHR * p, n = idx >> 4, kq = idx & 15; \
                u32x4 o; o.x = T[n * 65 + 4 * kq]; o.y = T[n * 65 + 4 * kq + 1]; o.z = T[n * 65 + 4 * kq + 2]; o.w = T[n * 65 + 4 * kq + 3]; \
                *(u32x4*)(DST + (size_t)n * KD + 8 * kq) = o; } } while (0)
        int t = bid;
        if (t < CT_TOTAL) CV_LOAD(ra, da, ga, Ka, sa, t);
        if (t + G < CT_TOTAL) CV_LOAD(rb, db, gb, Kb, sb, t + G);
        while (t < CT_TOTAL) {
            { bf16_t* cd = da; const int ck = Ka;
              CV_CONVERT(ra, ga, sa);
              if (t + 2 * G < CT_TOTAL) CV_LOAD(ra, da, ga, Ka, sa, t + 2 * G);
              __syncthreads();
              CV_STORE(cd, ck);
              __syncthreads(); }
            if (t + G >= CT_TOTAL) break;
            { bf16_t* cd = db; const int ck = Kb;
              CV_CONVERT(rb, gb, sb);
              if (t + 3 * G < CT_TOTAL) CV_LOAD(rb, db, gb, Kb, sb, t + 3 * G);
              __syncthreads();
              CV_STORE(cd, ck);
              __syncthreads(); }
            t += 2 * G;
        }
#undef CV_LOAD
#undef CV_CONVERT
#undef CV_STORE
    }
}

DI void compute_c2(const float* LF, int b, int h, LAS float* c2, LAS float* wtot) {
    int tid = threadIdx.x; asm volatile("" : "+v"(tid));
    const int lane = tid & 63, w = tid >> 6;
    const float* src = LF + ((size_t)b * NH + h) * LP;
    const int cbeg = w * 264, cend = cbeg + 264, p0 = cbeg + lane * 5;
    float v[5]; float run = 0.f;
#pragma unroll
    for (int e = 0; e < 5; ++e) { const int pos = p0 + e; const float x = (pos >= MOFF && pos < cend) ? src[pos] : 0.f; run += x; v[e] = run; }
    float incl = run;
#pragma unroll
    for (int o = 1; o < 64; o <<= 1) { const float t = __shfl_up(incl, o); if (lane >= o) incl += t; }
    const float excl = incl - run;
    if (lane == 63) wtot[w] = incl;
    __syncthreads();
    float wp = 0.f;
    for (int i = 0; i < w; ++i) wp += wtot[i];
#pragma unroll
    for (int e = 0; e < 5; ++e) { const int pos = p0 + e; if (pos < cend) c2[pos] = (pos < MOFF) ? __builtin_inff() : (wp + excl + v[e]) * LOG2E; }
    __syncthreads();
}

template <int TYPE>
DI void naive_attn_row(const unsigned char* ws, int b, int h, const bf16_t* qptr, int qpos, bf16_t* optr, const LAS float* c2, LAS float* sc, LAS float* qf) {
    int tid_ = threadIdx.x; asm volatile("" : "+v"(tid_));
    const int lane = tid_ & 63;
    const bf16_t* KB = (const bf16_t*)(ws + WS_KB); const bf16_t* VT = (const bf16_t*)(ws + WS_VT);
    { const unsigned qq = *(const unsigned*)(qptr + 2 * lane); qf[2 * lane] = bflo(qq); qf[2 * lane + 1] = bfhi(qq); }
    lds_fence();
    const int nkeys = (TYPE == 0) ? (qpos - MOFF + 1) : (qpos - MOFF);
    const int nk8 = (nkeys + 7) & ~7;
    for (int j = lane; j < nk8; j += 64) {
        float dot = 0.f;
        if (j < nkeys) {
            const u32x4* kp = (const u32x4*)(KB + ((size_t)b * LP + MOFF + j) * D + h * DH);
#pragma unroll 4
            for (int c = 0; c < 16; ++c) { const u32x4 kv = kp[c]; const f32x4 q0 = *(const LAS f32x4*)(qf + 8 * c), q1 = *(const LAS f32x4*)(qf + 8 * c + 4);
                dot += bflo(kv.x) * q0[0] + bfhi(kv.x) * q0[1] + bflo(kv.y) * q0[2] + bfhi(kv.y) * q0[3] + bflo(kv.z) * q1[0] + bfhi(kv.z) * q1[1] + bflo(kv.w) * q1[2] + bfhi(kv.w) * q1[3]; }
        }
        sc[j] = dot;
    }
    lds_fence();
    float inv = 1.f;
    if (TYPE == 0) {
        float m = -__builtin_inff();
        for (int j = lane; j < nkeys; j += 64) m = fmaxf(m, sc[j] - c2[MOFF + j]);
        m = wave_max(m);
        float l = 0.f;
        for (int j = lane; j < nk8; j += 64) { const float p = (j < nkeys) ? ex2(sc[j] - c2[MOFF + j] - m) : 0.f; l += p; sc[j] = p; }
        l = wave_sum(l); inv = 1.f / l;
    } else {
        float carry = 0.f;
        for (int top = nk8 - 1; top >= 0; top -= 64) {
            const int j = top - lane; const bool valid = (j >= 0) && (j < nkeys);
            const float y = (j >= 0) ? sc[j] : 0.f;
            const float sp = fmaxf(y, 0.f) + lg2(1.f + ex2(-fabsf(y)));
            const float lom = valid ? -sp : 0.f;
            float incl = lom;
#pragma unroll
            for (int o = 1; o < 64; o <<= 1) { const float t = __shfl_up(incl, o); if (lane >= o) incl += t; }
            const float a = valid ? ex2(y - sp + carry + (incl - lom)) : 0.f;
            if (j >= 0) sc[j] = a;
            carry += __shfl(incl, 63);
        }
    }
    lds_fence();
    float o0 = 0.f, o1 = 0.f;
    const bf16_t* v0 = VT + (size_t)(h * DH + 2 * lane) * VLD + b * LP + MOFF; const bf16_t* v1 = v0 + VLD;
#pragma unroll 2
    for (int j = 0; j < nk8; j += 8) {
        const u32x4 a = *(const u32x4*)(v0 + j), c = *(const u32x4*)(v1 + j);
        const f32x4 p0 = *(const LAS f32x4*)(sc + j), p1 = *(const LAS f32x4*)(sc + j + 4);
        o0 += bflo(a.x) * p0[0] + bfhi(a.x) * p0[1] + bflo(a.y) * p0[2] + bfhi(a.y) * p0[3] + bflo(a.z) * p1[0] + bfhi(a.z) * p1[1] + bflo(a.w) * p1[2] + bfhi(a.w) * p1[3];
        o1 += bflo(c.x) * p0[0] + bfhi(c.x) * p0[1] + bflo(c.y) * p0[2] + bfhi(c.y) * p0[3] + bflo(c.z) * p1[0] + bfhi(c.z) * p1[1] + bflo(c.w) * p1[2] + bfhi(c.w) * p1[3];
    }
    *(unsigned*)(optr + 2 * lane) = pk2(o0 * inv, o1 * inv);
    lds_fence();
}

constexpr int AT_C2 = 0, AT_WTOT = 8448, AT_K0 = 8704, AT_KSZ = 64 * 272, AT_V0 = AT_K0 + 2 * AT_KSZ, AT_VSZ = 128 * 144;
constexpr int NA_SC = 8704, NA_QF = NA_SC + 8 * 2064 * 4;
static_assert(AT_V0 + 3 * AT_VSZ <= 131072 && NA_QF + 8 * 128 * 4 <= 131072, "attention LDS");

DI int swap23(int m) { return (m & 0x13) | ((m & 4) << 1) | ((m & 8) >> 1); }

template <int TYPE>
DI void attn_item(const unsigned char* ws_in, LAS unsigned char* lds, int b, int h, int qb) {
    const unsigned char* ws = ws_in + opaque0();
    int tid = threadIdx.x; asm volatile("" : "+v"(tid));
    const int lane = tid & 63, w = __builtin_amdgcn_readfirstlane(tid >> 6), m32 = lane & 31, g = lane >> 5;
    const bf16_t* QB = (const bf16_t*)(ws + WS_QB); const bf16_t* KB = (const bf16_t*)(ws + WS_KB); const bf16_t* VT = (const bf16_t*)(ws + WS_VT);
    bf16_t* OB = (bf16_t*)(ws + WS_OB);
    const LAS float* c2 = (const LAS float*)(lds + AT_C2);
    const int nkt = 4 * qb + 5;
    const int prow0 = ROFF + 256 * qb + 32 * w, plast = prow0 + 31, qp = prow0 + m32;
    const int tok = b * SEQ + 256 * qb + 32 * w + m32;
    bf16x8 Q[8];
    { const bf16_t* qptr = QB + (size_t)tok * D + h * DH + 8 * g;
#pragma unroll
      for (int ks = 0; ks < 8; ++ks) Q[ks] = *(const bf16x8*)(qptr + 16 * ks); }
    f32x16 O[4];
#pragma unroll
    for (int i = 0; i < 4; ++i)
#pragma unroll
        for (int a = 0; a < 16; ++a) O[i][a] = 0.f;
    float mrun = -__builtin_inff(), lrun = 0.f, carry = 1.f;
    u32x4 kreg[2], vreg[2];
    const bf16_t* kbase = KB + (size_t)b * LP * D + h * DH;
    const bf16_t* vbase = VT + (size_t)h * DH * VLD + b * LP;
#define AT_LOAD(kt) do { _Pragma("unroll") for (int i = 0; i < 2; ++i) { const int ch = tid + NTHR * i; \
        kreg[i] = *(const u32x4*)(kbase + (size_t)(64 * (kt) + (ch >> 4)) * D + 8 * (ch & 15)); \
        vreg[i] = *(const u32x4*)(vbase + (size_t)(ch >> 3) * VLD + 64 * (kt) + 8 * (ch & 7)); } } while (0)
#define AT_STORE(kbuf, vbuf) do { _Pragma("unroll") for (int i = 0; i < 2; ++i) { const int ch = tid + NTHR * i; \
        *(LAS u32x4*)(lds + AT_K0 + (kbuf) * AT_KSZ + (ch >> 4) * 272 + (ch & 15) * 16) = kreg[i]; \
        *(LAS u32x4*)(lds + AT_V0 + (vbuf) * AT_VSZ + (ch >> 3) * 144 + (ch & 7) * 16) = vreg[i]; } } while (0)
#define AT_PV(vbuf) do { const LAS unsigned char* vb_ = lds + AT_V0 + (vbuf) * AT_VSZ; \
        _Pragma("unroll") for (int db = 0; db < 4; ++db) _Pragma("unroll") for (int blk = 0; blk < 2; ++blk) _Pragma("unroll") for (int s = 0; s < 2; ++s) { \
            const bf16x8 vf = *(const LAS bf16x8*)(vb_ + (32 * db + m32) * 144 + 64 * blk + 32 * s + 16 * g); \
            O[db] = __builtin_amdgcn_mfma_f32_32x32x16_bf16(vf, Pf[blk][s], O[db], 0, 0, 0); } } while (0)
    __syncthreads();
    if (TYPE == 1 && tid < 3) ((volatile LAS unsigned*)(lds + AT_WTOT))[tid] = 0u;
    { const int kt0 = (TYPE == 0) ? 0 : nkt - 1; AT_LOAD(kt0); AT_STORE(0, 0); }
    __syncthreads();
    const int krow = swap23(m32);
    const bool grpB = (w >= 4);
    bf16x8 Pf[2][2];
    bool pend = false; int vprev = 0, vcur = 0;
    volatile LAS unsigned* dcnt = (volatile LAS unsigned*)(lds + AT_WTOT);
    bool wdone = false; int dc = 0;
    for (int it = 0; it <= nkt; ++it) {
        if (TYPE == 1) {
            const int dn = (dc == 2) ? 0 : dc + 1, dz = (dn == 2) ? 0 : dn + 1;
            if (dcnt[dc] == 8u) { if (pend) { AT_PV(vprev); pend = false; } break; }
            if (tid == 0) dcnt[dz] = 0u;
            if (wdone && lane == 0) __hip_atomic_fetch_add((LAS unsigned*)(lds + AT_WTOT) + dn, 1u, __ATOMIC_RELAXED, __HIP_MEMORY_SCOPE_WORKGROUP);
            dc = dn;
        }
        const bool have = it < nkt;
        const int kt = (TYPE == 0) ? it : nkt - 1 - it, cur = it & 1;
        const bool more = it + 1 < nkt;
        const int vnext = (vcur == 2) ? 0 : vcur + 1;
        if (more) { const int ktn = (TYPE == 0) ? it + 1 : nkt - 2 - it; AT_LOAD(ktn); }
        if (pend) { AT_PV(vprev); pend = false; }
        if (have && 64 * kt <= plast && !wdone) {
            const LAS unsigned char* kb = lds + AT_K0 + cur * AT_KSZ;
            f32x16 S[2];
#pragma unroll
            for (int blk = 0; blk < 2; ++blk) {
                if (TYPE == 0) {
#pragma unroll
                    for (int s = 0; s < 2; ++s) { const int kp0 = 64 * kt + 32 * blk + 16 * s + 8 * g;
                        const f32x4 ca = *(const LAS f32x4*)(c2 + kp0), cb = *(const LAS f32x4*)(c2 + kp0 + 4);
#pragma unroll
                        for (int e = 0; e < 4; ++e) { S[blk][8 * s + e] = -ca[e]; S[blk][8 * s + 4 + e] = -cb[e]; } }
                } else {
#pragma unroll
                    for (int a = 0; a < 16; ++a) S[blk][a] = 0.f;
                }
#pragma unroll
                for (int ks = 0; ks < 8; ++ks) {
                    const bf16x8 kf = *(const LAS bf16x8*)(kb + (32 * blk + krow) * 272 + 32 * ks + 16 * g);
                    S[blk] = __builtin_amdgcn_mfma_f32_32x32x16_bf16(kf, Q[ks], S[blk], 0, 0, 0);
                }
            }
            const bool diag = (64 * kt + 63 >= prow0);
            if (TYPE == 0) {
                float mx = -__builtin_inff();
#define FOX_SCORE(MASKED) _Pragma("unroll") for (int blk = 0; blk < 2; ++blk) _Pragma("unroll") for (int s = 0; s < 2; ++s) { \
                        const int kp0 = 64 * kt + 32 * blk + 16 * s + 8 * g; \
                        _Pragma("unroll") for (int e = 0; e < 8; ++e) { \
                            float sv = S[blk][8 * s + e]; \
                            if (MASKED) { if (kp0 + e > qp) sv = -__builtin_inff(); } \
                            S[blk][8 * s + e] = sv; mx = fmaxf(mx, sv); } }
                if (diag) { FOX_SCORE(true) } else { FOX_SCORE(false) }
#undef FOX_SCORE
                mx = fmaxf(mx, xor32(mx, lane));
                const float mnew = fmaxf(mrun, mx);
                const float alpha = ex2(mrun - mnew);
                mrun = mnew;
                float rs = 0.f;
#pragma unroll
                for (int blk = 0; blk < 2; ++blk)
#pragma unroll
                    for (int s = 0; s < 2; ++s) {
                        float p[8];
#pragma unroll
                        for (int e = 0; e < 8; ++e) { p[e] = ex2(S[blk][8 * s + e] - mnew); rs += p[e]; }
                        u32x4 pw; pw.x = pk2(p[0], p[1]); pw.y = pk2(p[2], p[3]); pw.z = pk2(p[4], p[5]); pw.w = pk2(p[6], p[7]);
                        Pf[blk][s] = __builtin_bit_cast(bf16x8, pw);
                    }
                lrun = lrun * alpha + rs;
                if (__builtin_amdgcn_ballot_w64(alpha != 1.0f) != 0ull) {
#pragma unroll
                    for (int i = 0; i < 4; ++i)
#pragma unroll
                        for (int a = 0; a < 16; ++a) O[i][a] *= alpha;
                }
            } else {
                float T[2][2];
                const unsigned qlim = (unsigned)(qp - MOFF);
                const bool msk = diag || kt == 0;
#pragma unroll
                for (int blk = 0; blk < 2; ++blk)
#pragma unroll
                    for (int s = 0; s < 2; ++s) {
                        const int kp0 = 64 * kt + 32 * blk + 16 * s + 8 * g;
                        float run = 1.f;
#pragma unroll
                        for (int e = 7; e >= 0; --e) {
                            float y = S[blk][8 * s + e];
                            if (msk) y = ((unsigned)(kp0 + e - MOFF) < qlim) ? y : -126.f;
                            const float t = ex2(-fmaxf(y, -126.f));
                            const float beta = __builtin_amdgcn_rcpf(1.f + t), omb = t * beta;
                            S[blk][8 * s + e] = beta * run; run *= omb;
                        }
                        T[blk][s] = run;
                    }
                float PT[2][2];
#pragma unroll
                for (int blk = 0; blk < 2; ++blk)
#pragma unroll
                    for (int s = 0; s < 2; ++s) PT[blk][s] = xor32(T[blk][s], lane);
                float off[2][2]; float accu = carry;
#pragma unroll
                for (int blk = 1; blk >= 0; --blk)
#pragma unroll
                    for (int s = 1; s >= 0; --s) { off[blk][s] = (g == 0) ? accu * PT[blk][s] : accu; accu *= T[blk][s] * PT[blk][s]; }
                carry = accu;
                if (__builtin_amdgcn_ballot_w64(carry >= 7.888609e-31f) == 0ull) { wdone = true;
                    if (lane == 0) __hip_atomic_fetch_add((LAS unsigned*)(lds + AT_WTOT) + dc, 1u, __ATOMIC_RELAXED, __HIP_MEMORY_SCOPE_WORKGROUP); }
#pragma unroll
                for (int blk = 0; blk < 2; ++blk)
#pragma unroll
                    for (int s = 0; s < 2; ++s) {
                        float p[8];
#pragma unroll
                        for (int e = 0; e < 8; ++e) p[e] = S[blk][8 * s + e] * off[blk][s];
                        u32x4 pw; pw.x = pk2(p[0], p[1]); pw.y = pk2(p[2], p[3]); pw.z = pk2(p[4], p[5]); pw.w = pk2(p[6], p[7]);
                        Pf[blk][s] = __builtin_bit_cast(bf16x8, pw);
                    }
            }
            if (grpB) { pend = true; vprev = vcur; } else { AT_PV(vcur); }
        }
        if (more) AT_STORE(cur ^ 1, vnext);
        __syncthreads();
        vcur = vnext;
    }
#undef AT_LOAD
#undef AT_STORE
#undef AT_PV
    float inv = 1.f;
    if (TYPE == 0) { const float lt = lrun + xor32(lrun, lane); inv = 1.f / lt; }
    bf16_t* op = OB + (size_t)tok * D + h * DH + 4 * g;
#pragma unroll
    for (int db = 0; db < 4; ++db)
#pragma unroll
        for (int i = 0; i < 4; ++i) {
            u32x2 o; o.x = pk2(O[db][4 * i] * inv, O[db][4 * i + 1] * inv); o.y = pk2(O[db][4 * i + 2] * inv, O[db][4 * i + 3] * inv);
            *(u32x2*)(op + 32 * db + 8 * i) = o;
        }
}

DI void attn_phase(const Params& P, LAS unsigned char* lds, int layer, int G, int bid, int vcu) {
    int tid = threadIdx.x; asm volatile("" : "+v"(tid));
    const int w = tid >> 6;
    const unsigned char* ws = P.ws + opaque0();
    const float* LF = (const float*)(ws + WS_LF);
    LAS float* c2 = (LAS float*)(lds + AT_C2); LAS float* wtot = (LAS float*)(lds + AT_WTOT);
    LAS float* sc = (LAS float*)(lds + NA_SC) + w * 2064; LAS float* qf = (LAS float*)(lds + NA_QF) + w * 128;
    const bool fox = layer < 2;
    if (fox) {
        for (int it = bid; it < 32; it += G) {
            const int h = it >> 1, r = (it & 1) * 8 + w;
            compute_c2(LF, 0, h, c2, wtot);
            naive_attn_row<0>(ws, 0, h, (const bf16_t*)(ws + WS_QM) + (size_t)r * D + h * DH, MOFF + r, (bf16_t*)(P.ws + WS_OM) + (size_t)r * D + h * DH, c2, sc, qf);
            __syncthreads();
        }
    }
    const bool naive = fox ? (NAIVE_FOX != 0) : (NAIVE_SB != 0);
    if (naive) {
        for (int it = bid; it < NB * NH * 256; it += G) {
            const int bh = it >> 8, b = bh >> 4, h = bh & 15, t = (it & 255) * 8 + w;
            if (fox) compute_c2(LF, b, h, c2, wtot);
            const bf16_t* qptr = (const bf16_t*)(ws + WS_QB) + (size_t)(b * SEQ + t) * D + h * DH; bf16_t* optr = (bf16_t*)(P.ws + WS_OB) + (size_t)(b * SEQ + t) * D + h * DH;
            if (fox) naive_attn_row<0>(ws, b, h, qptr, ROFF + t, optr, c2, sc, qf); else naive_attn_row<1>(ws, b, h, qptr, ROFF + t, optr, c2, sc, qf);
            __syncthreads();
        }
    } else {
        for (int it = vcu; it < NB * NH * 4; it += G) {
            const int bh = it >> 2, b = bh >> 4, h = bh & 15, p = it & 3;
            if (fox) { __syncthreads(); compute_c2(LF, b, h, c2, wtot);
#pragma nounroll
                for (int hf = 0; hf < 2; ++hf) attn_item<0>(ws, lds, b, h, hf ? p : 7 - p); }
            else {
#pragma nounroll
                for (int hf = 0; hf < 2; ++hf) attn_item<1>(ws, lds, b, h, hf ? p : 7 - p); }
        }
    }
    __syncthreads();
}

DI EpiCtx make_epi(const Params& P, unsigned char* ws, int l, int kind) {
    u64* ssq = (u64*)(ws + WS_SSQ); u64* ssqm = (u64*)(ws + WS_SSQM);
    EpiCtx e{}; e.ws = ws; e.bfg = P.fox_b_f + (l < 2 ? l : 0) * NH; e.rsc = 1.f;
    e.ssq_in = ssq; e.ssqm_in = ssqm; e.ssq_out = ssq; e.ssqm_out = ssqm; e.hin = nullptr; e.hmin = (const float*)(ws + WS_HM);
    if (kind == 0) { e.ssq_in = ssq + (size_t)(2 * l) * MR; e.ssqm_in = ssqm + (2 * l) * 16; }
    else if (kind == 2) { if (l == 0) { e.hmin = P.meta; }     e.ssq_out = ssq + (size_t)(2 * l + 1) * MR; e.ssqm_out = ssqm + (2 * l + 1) * 16; }
    else if (kind == 3) { e.ssq_in = ssq + (size_t)(2 * l + 1) * MR; e.ssqm_in = ssqm + (2 * l + 1) * 16; }
    else { e.ssq_out = ssq + (size_t)(2 * l + 2) * MR; e.ssqm_out = ssqm + (2 * l + 2) * 16; }
    return e;
}
DI const bf16_t* phase_w(unsigned char* ws, int l, int kind) {
    if (kind == 0) return (l < 2) ? (const bf16_t*)(ws + WS_WT_IN) + (size_t)l * 3 * D * D : (l == 2 ? (const bf16_t*)(ws + WS_WT_QKV2) : (const bf16_t*)(ws + WS_WT_Q3));
    if (kind == 2) return (l < 2) ? (const bf16_t*)(ws + WS_WT_O) + (size_t)l * D * D : (const bf16_t*)(ws + WS_WT_SO) + (size_t)(l - 2) * D * D;
    if (kind == 3) return (const bf16_t*)(ws + WS_WT_UP) + (size_t)l * FF * D;
    return (const bf16_t*)(ws + WS_WT_DN) + (size_t)l * D * FF;
}
DI pg8::Sched make_sched(unsigned char* ws, int l, int kind, int G, int bid) {
    pg8::Sched S{}; S.G = G; S.c = bid; S.K = (kind == 4) ? FF : D;
    const bf16_t* W = phase_w(ws, l, kind); const bf16_t* HB = (const bf16_t*)(ws + WS_HB);
    S.A0 = HB; S.B0 = W; S.nM0 = 32; S.nN0 = 8; S.ek0 = E_RES; S.A1 = W; S.B1 = HB; S.nM1 = 0; S.nN1 = 0; S.ek1 = E_VT;
    if (kind == 0) { S.nN0 = (l < 3) ? 16 : 8; S.ek0 = E_QK; if (l < 3) { S.A1 = W + (size_t)2 * D * D; S.nM1 = 8; S.nN1 = 32; } }
    else if (kind == 2) { S.A0 = (const bf16_t*)(ws + WS_OB); }
    else if (kind == 3) { S.nN0 = 32; S.ek0 = E_UP; }
    else { S.A0 = (const bf16_t*)(ws + WS_UB); S.ablk = !NAIVE_GEMM; }
    return S;
}
DI SkJob make_job(unsigned char* ws, int l, int kind, int q) {
    SkJob j{}; j.kind = JK_NONE;
    const bf16_t* W = phase_w(ws, l, kind); const bf16_t* HB = (const bf16_t*)(ws + WS_HB); const bf16_t* HBM = (const bf16_t*)(ws + WS_HBM);
    if (q == 0) {
        if (kind == 0) { if (l < 2) j = {HBM, W, D, 384, JK_META_IN, 0, 0, 0, 0}; else if (l == 2) j = {HBM, W + (size_t)D * D, D, 256, JK_META_IN, D, 0, 0, 0}; }
        else if (l < 2) {
            if (kind == 2) j = {(const bf16_t*)(ws + WS_OM), W, D, 128, JK_META_RES, 0, 0, 0, 0};
            else if (kind == 3) j = {HBM, W, D, 512, JK_META_UP, 0, 0, 0, 0};
            else j = {(const bf16_t*)(ws + WS_UM), W, FF, 128, JK_META_RES, 0, 0, 0, 0};
        }
    } else if (q <= 2) {
        if (kind == 0 && l < 2) {
            const bf16_t* WF = (const bf16_t*)(ws + WS_WF) + (size_t)l * 16 * D;
            if (q == 1) j = {WF, HB, D, MR / 16, JK_FG, 0, 0, 0, 0}; else j = {WF, HBM, D, 1, JK_FG_META, 0, 0, 0, 0};
        }
    } else {
        const pg8::Sched S = make_sched(ws, l, kind, 1, 0);
        if (q == 3) j = {S.A0, S.B0, S.K, S.nM0 * 16 * S.nN0 * 16, JK_NAIVE, 0, S.ek0, S.nN0 * 16, 0};
        else j = {S.A1, S.B1, S.K, S.nM1 * 16 * S.nN1 * 16, JK_NAIVE, 0, S.ek1, S.nN1 * 16, 0};
    }
    return j;
}

__global__ void __launch_bounds__(NTHR, 2) yoco_mega(Params P) {
    extern __shared__ __attribute__((aligned(16))) unsigned char smem[];
    LAS unsigned char* lds = (LAS unsigned char*)smem;
    cg::grid_group grid = cg::this_grid();
    const int G = gridDim.x, bid = blockIdx.x;
    unsigned char* ws = P.ws;
    const unsigned xcc = (unsigned)__builtin_amdgcn_s_getreg((3 << 11) | 20) & 7u;
    {
        LAS unsigned* lw = (LAS unsigned*)(lds + LDS_BYTES - 16);
        if (threadIdx.x == 0) lw[0] = __hip_atomic_fetch_add((unsigned*)(ws + WS_BAR) + 8 + xcc, 1u, __ATOMIC_RELAXED, __HIP_MEMORY_SCOPE_AGENT);
        __syncthreads();
    }
    const unsigned xrank = __builtin_amdgcn_readfirstlane(((LAS unsigned*)(lds + LDS_BYTES - 16))[0]);
    phase0(P, lds, G, bid);
#if DUP_P0
    __syncthreads(); phase0(P, lds, G, bid);
#endif
    asm volatile("s_waitcnt vmcnt(0) lgkmcnt(0)" ::: "memory");
    grid.sync();
    unsigned* barcnt = (unsigned*)(ws + WS_BAR); unsigned nbar = 0;
    int vcu;
    bool xok; unsigned kx = 0;
    {
        bool ok = (G == 256);
        for (int i = 0; i < 8; ++i) ok = ok && (__hip_atomic_load((unsigned*)(ws + WS_BAR) + 8 + i, __ATOMIC_RELAXED, __HIP_MEMORY_SCOPE_AGENT) == 32u);
        vcu = ok ? (int)(xcc * 32u + xrank) : ((G % 8 == 0) ? (bid % 8) * (G / 8) + bid / 8 : bid);
        xok = ok;
    }
#define GBAR() do { if (xok) grid_bar_x(barcnt, xcc, ++kx); else grid_bar(barcnt, ++nbar * (unsigned)G); } while (0)
    const int vc = (G % 8 == 0) ? (vcu % (G / 8)) * 8 + vcu / (G / 8) : vcu;
#pragma nounroll
    for (int step0 = 0; step0 < 20 + DUP_STEP; ++step0) {
        const int step = (DUP_STEP && step0 > DUP_STEP_AT) ? step0 - 1 : step0;
        const int l = step / 5, kind = step % 5;
        if (kind == 1) { attn_phase(P, lds, l, G, bid, vcu);
#if DUP_FOX
            if (l == 0) attn_phase(P, lds, l, G, bid, vcu);
#endif
#if DUP_SB
            if (l == 2) attn_phase(P, lds, l, G, bid, vcu);
#endif
        }
        else {
#if !NAIVE_GEMM
            {
                unsigned char* wsl = P.ws + opaque0();
                const EpiCtx e = make_epi(P, wsl, l, kind);
                const pg8::Sched S = make_sched(wsl, l, kind, G, vc);
                pg8::gemm_phase(lds, S, e);
#if DUP_UP
                if (kind == 3 && l == 0) pg8::gemm_phase(lds, S, e);
#endif
#if DUP_RES
                if (kind == DUP_RES && l == 0) { GBAR(); EpiCtx e2 = e; e2.rsc = 0.f; e2.hin = nullptr; pg8::Sched S2 = S; S2.pmmask = DUP_PMMASK; pg8::gemm_phase(lds, S2, e2); }
#endif
            }
#endif
#pragma nounroll
            for (int q = 0; q < (NAIVE_GEMM ? 5 : 3); ++q) {
                unsigned char* wsl = P.ws + opaque0();
                const EpiCtx e = make_epi(P, wsl, l, kind);
                const SkJob jb = make_job(wsl, l, kind, q);
                skinny_items(jb, e, lds, G, bid);
            }
        }
        GBAR();
    }
#if DUP_BAR
    for (int i = 0; i < DUP_BAR; ++i) GBAR();
#endif
    {
        int tid = threadIdx.x; asm volatile("" : "+v"(tid));
        const int lane = tid & 63, w = tid >> 6;
        const u64* ssq = (const u64*)(ws + WS_SSQ) + (size_t)8 * MR; const bf16_t* hb = (const bf16_t*)(ws + WS_HB);
        for (int r = bid * 8 + w; r < MR; r += G * 8) {
            const float rs = rstd_of(ssq[r]);
            const u32x4* src = (const u32x4*)(hb + (size_t)r * D) + lane; const f32x4* gg = (const f32x4*)P.final_norm; f32x4* dst = (f32x4*)(P.out + (size_t)r * D);
#pragma unroll
            for (int j = 0; j < 4; ++j) {
                const u32x4 t = src[64 * j]; const int c4 = (lane + 64 * j) * 2;
                const f32x4 a0 = {bflo(t.x), bfhi(t.x), bflo(t.y), bfhi(t.y)}, a1 = {bflo(t.z), bfhi(t.z), bflo(t.w), bfhi(t.w)};
                dst[c4] = a0 * rs * gg[c4]; dst[c4 + 1] = a1 * rs * gg[c4 + 1];
            }
        }
    }
}

extern "C" void kernel_launch(void* const* d_in, const int* in_sizes, int n_in, void* d_out, int out_size, void* d_ws, size_t ws_size, hipStream_t stream) {
    static int grid = 0;
    if (grid == 0) {
        if (n_in != 14 || out_size != MR * D || ws_size < WS_END) { fprintf(stderr, "kernel_launch: unexpected shapes (n_in %d out %d ws %zu need %zu)\n", n_in, out_size, ws_size, (size_t)WS_END); grid = -1; return; }
        int dev = 0, cus = 0, per_cu = 0;
        hipGetDevice(&dev);
        hipDeviceGetAttribute(&cus, hipDeviceAttributeMultiprocessorCount, dev);
        if (hipFuncSetAttribute((const void*)yoco_mega, hipFuncAttributeMaxDynamicSharedMemorySize, LDS_BYTES) != hipSuccess) { fprintf(stderr, "kernel_launch: hipFuncSetAttribute failed\n"); grid = -1; return; }
        hipOccupancyMaxActiveBlocksPerMultiprocessor(&per_cu, (const void*)yoco_mega, NTHR, LDS_BYTES);
        (void)hipGetLastError();
        if (per_cu < 1) per_cu = 1;
        grid = cus * 1;
        fprintf(stderr, "kernel_launch: cus %d per_cu %d grid %d\n", cus, per_cu, grid);
    }
    if (grid < 0) return;
    Params p{};
    p.x = (const float*)d_in[0]; p.meta = (const float*)d_in[1]; p.norm_attn = (const float*)d_in[2]; p.norm_mlp = (const float*)d_in[3];
    p.w_up = (const float*)d_in[4]; p.w_down = (const float*)d_in[5]; p.fox_w_in = (const float*)d_in[6]; p.fox_b_f = (const float*)d_in[7];
    p.fox_w_o = (const float*)d_in[8]; p.kv_norm = (const float*)d_in[9]; p.w_kv = (const float*)d_in[10]; p.sb_w_q = (const float*)d_in[11];
    p.sb_w_o = (const float*)d_in[12]; p.final_norm = (const float*)d_in[13];
    p.out = (float*)d_out; p.ws = (unsigned char*)d_ws;
    if (hipMemsetAsync((unsigned char*)d_ws + WS_BAR, 0, 256, stream) != hipSuccess) { fprintf(stderr, "kernel_launch: memset failed\n"); return; }
    void* args[] = {&p};
    hipError_t e = hipLaunchCooperativeKernel((const void*)yoco_mega, dim3(grid), dim3(NTHR), args, LDS_BYTES, stream);
    if (e != hipSuccess) fprintf(stderr, "cooperative launch failed: %s (grid %d)\n", hipGetErrorString(e), grid);
}
```

```cpp
#include <hip/hip_runtime.h>
#include <hip/hip_cooperative_groups.h>
#include <cstdio>
#include <cstdint>
namespace cg = cooperative_groups;

#ifndef NAIVE_GEMM
#define NAIVE_GEMM 0
#endif
#ifndef NAIVE_FOX
#define NAIVE_FOX 0
#endif
#ifndef NAIVE_SB
#define NAIVE_SB 0
#endif

#ifndef GEMM_SP2
#define GEMM_SP2 1
#endif
#ifndef DUP_STEP
#define DUP_STEP 0
#endif
#ifndef DUP_STEP_AT
#define DUP_STEP_AT 3
#endif
#ifndef DUP_RES
#define DUP_RES 0
#endif
#ifndef DUP_PMMASK
#define DUP_PMMASK 0
#endif
#ifndef DUP_BAR
#define DUP_BAR 0
#endif
#ifndef DUP_P0
#define DUP_P0 0
#endif
#ifndef DUP_FOX
#define DUP_FOX 0
#endif
#ifndef DUP_SB
#define DUP_SB 0
#endif
#ifndef DUP_UP
#define DUP_UP 0
#endif
#define LAS __attribute__((address_space(3)))
#define DI __device__ __forceinline__
typedef unsigned short bf16_t;
typedef short bf16x8 __attribute__((ext_vector_type(8)));
typedef float f32x4 __attribute__((ext_vector_type(4)));
typedef float f32x16 __attribute__((ext_vector_type(16)));
typedef unsigned u32x4 __attribute__((ext_vector_type(4)));
typedef unsigned u32x2 __attribute__((ext_vector_type(2)));

constexpr int D = 2048, NB = 4, SEQ = 2048, NH = 16, DH = 128, FF = 8192, NMETA = 16;
constexpr int MR = NB * SEQ;
constexpr int LP = 2112;
constexpr int MOFF = 48, ROFF = 64;
constexpr int NIN = 3 * D + NH;
constexpr int VLD = NB * LP;
constexpr float EPS = 1e-6f;
constexpr float LOG2E = 1.4426950408889634f;
constexpr float QSCALE = 0.08838834764831845f * LOG2E;
constexpr int NTHR = 512;
constexpr int LDS_BYTES = 147456;

constexpr size_t SZ_DD = (size_t)D * D * 2;
constexpr size_t WS_WT_IN = 0;
constexpr size_t WS_WF = WS_WT_IN + 2 * 3 * SZ_DD;
constexpr size_t WS_WT_O = WS_WF + 2 * 16 * D * 2;
constexpr size_t WS_WT_UP = WS_WT_O + 2 * SZ_DD;
constexpr size_t WS_WT_DN = WS_WT_UP + 4 * 4 * SZ_DD;
constexpr size_t WS_WT_QKV2 = WS_WT_DN + 4 * 4 * SZ_DD;
constexpr size_t WS_WT_Q3 = WS_WT_QKV2 + 3 * SZ_DD;
constexpr size_t WS_WT_SO = WS_WT_Q3 + SZ_DD;
constexpr size_t WS_H = WS_WT_SO + 2 * SZ_DD;
constexpr size_t WS_HB = WS_H + (size_t)MR * D * 4;
constexpr size_t WS_QB = WS_HB + (size_t)MR * D * 2;
constexpr size_t WS_KB = WS_QB + (size_t)MR * D * 2;
constexpr size_t WS_VT = WS_KB + (size_t)NB * LP * D * 2;
constexpr size_t WS_OB = WS_VT + (size_t)D * VLD * 2;
constexpr size_t WS_UB = WS_OB + (size_t)MR * D * 2;
constexpr size_t WS_SSQ = WS_UB + (size_t)MR * FF * 2;
constexpr size_t WS_LF = WS_SSQ + 9 * (size_t)MR * 8;
constexpr size_t WS_HM = WS_LF + (size_t)NB * NH * LP * 4;
constexpr size_t WS_HBM = WS_HM + 16 * D * 4;
constexpr size_t WS_QM = WS_HBM + 16 * D * 2;
constexpr size_t WS_OM = WS_QM + 16 * D * 2;
constexpr size_t WS_UM = WS_OM + 16 * D * 2;
constexpr size_t WS_SSQM = WS_UM + 16 * FF * 2;
constexpr size_t WS_BAR = (WS_SSQM + 9 * 16 * 8 + 255) / 256 * 256;
constexpr size_t WS_END = WS_BAR + 256;

struct Params {
    const float *x, *meta, *norm_attn, *norm_mlp, *w_up, *w_down, *fox_w_in, *fox_b_f, *fox_w_o, *kv_norm, *w_kv, *sb_w_q, *sb_w_o, *final_norm;
    float* out; unsigned char* ws;
};

DI unsigned f2bf(float f) { unsigned u = __float_as_uint(f); u += 0x7FFFu + ((u >> 16) & 1u); return u >> 16; }
typedef float f32x2_t __attribute__((ext_vector_type(2)));
typedef __bf16 bf16x2_t __attribute__((ext_vector_type(2)));
DI unsigned pk2(float lo, float hi) { f32x2_t v = {lo, hi}; return __builtin_bit_cast(unsigned, __builtin_convertvector(v, bf16x2_t)); }
DI float bf2f(unsigned short b) { return __uint_as_float(((unsigned)b) << 16); }
DI float bflo(unsigned w) { return __uint_as_float(w << 16); }
DI float bfhi(unsigned w) { return __uint_as_float(w & 0xFFFF0000u); }
DI float ex2(float x) { return __builtin_amdgcn_exp2f(x); }
DI float lg2(float x) { return __builtin_amdgcn_logf(x); }
typedef unsigned long long u64;
constexpr float SSQ_SCALE = 16777216.0f;
DI float rstd_of(u64 ssq) { const float f = (float)(unsigned)(ssq >> 32) * 4294967296.0f + (float)(unsigned)ssq;
    return __builtin_amdgcn_rsqf(f * (1.0f / (SSQ_SCALE * D)) + EPS); }
DI u64 ssq_fix(float s) { return (u64)(s * SSQ_SCALE + 0.5f); }
DI int prow_of(int tok) { return (tok >> 11) * LP + ROFF + (tok & 2047); }
DI float wave_sum(float v) {
#pragma unroll
    for (int o = 1; o < 64; o <<= 1) v += __shfl_xor(v, o);
    return v;
}
DI float wave_max(float v) {
#pragma unroll
    for (int o = 1; o < 64; o <<= 1) v = fmaxf(v, __shfl_xor(v, o));
    return v;
}
DI size_t opaque0() { size_t z = 0; asm volatile("" : "+s"(z)); return z; }
DI float xor32(float x, int lane) {
    const unsigned u = __float_as_uint(x); const auto r = __builtin_amdgcn_permlane32_swap(u, u, false, false);
    return __uint_as_float((lane & 32) ? r[0] : r[1]); }
DI void lds_fence() { asm volatile("s_waitcnt lgkmcnt(0)" ::: "memory"); __builtin_amdgcn_wave_barrier(); }

DI void grid_bar(unsigned* cnt, unsigned target) {
    asm volatile("s_waitcnt vmcnt(0) lgkmcnt(0)" ::: "memory");
    __syncthreads();
    if (threadIdx.x == 0) {
        __builtin_amdgcn_fence(__ATOMIC_RELEASE, "agent");
        __hip_atomic_fetch_add(cnt, 1u, __ATOMIC_RELAXED, __HIP_MEMORY_SCOPE_AGENT);
        while (__hip_atomic_load(cnt, __ATOMIC_RELAXED, __HIP_MEMORY_SCOPE_AGENT) < target) __builtin_amdgcn_s_sleep(2);
        __builtin_amdgcn_fence(__ATOMIC_ACQUIRE, "agent");
    }
    __syncthreads();
}

DI void grid_bar_x(unsigned* base, unsigned xcc, unsigned k) {
    asm volatile("s_waitcnt vmcnt(0) lgkmcnt(0)" ::: "memory");
    __syncthreads();
    if (threadIdx.x == 0) {
        const unsigned old = __hip_atomic_fetch_add(base + 16 + xcc, 1u, __ATOMIC_RELAXED, __HIP_MEMORY_SCOPE_AGENT);
        if (old + 1u == 32u * k) {
            __builtin_amdgcn_fence(__ATOMIC_RELEASE, "agent");
            __hip_atomic_fetch_add(base + 24, 1u, __ATOMIC_RELAXED, __HIP_MEMORY_SCOPE_AGENT);
        }
        while (__hip_atomic_load(base + 24, __ATOMIC_RELAXED, __HIP_MEMORY_SCOPE_AGENT) < 8u * k) { }
        __builtin_amdgcn_fence(__ATOMIC_ACQUIRE, "agent");
    }
    __syncthreads();
}

enum { E_QK = 0, E_VT = 1, E_FG = 2, E_RES = 3, E_UP = 4 };
struct EpiCtx {
    unsigned char* ws;
    const u64* ssq_in;  const u64* ssqm_in;
    u64* ssq_out; u64* ssqm_out;
    const float* hin; const float* hmin;
    const float* bfg;
    float rsc;
};

DI float epi_elem(const EpiCtx& e, int ek, bool meta, int row, int col, float v) {
    unsigned char* ws = e.ws;
    if (ek == E_QK) {
        const float val = v * rstd_of(meta ? e.ssqm_in[row] : e.ssq_in[row]);
        const bf16_t o = (bf16_t)f2bf(val);
        if (col < D) { bf16_t* q = (bf16_t*)(ws + (meta ? WS_QM : WS_QB)); q[(size_t)row * D + col] = o; }
        else {
            bf16_t* kb = (bf16_t*)(ws + WS_KB);
            if (meta) { for (int b = 0; b < NB; ++b) kb[((size_t)b * LP + MOFF + row) * D + (col - D)] = o; }
            else kb[(size_t)prow_of(row) * D + (col - D)] = o;
        }
        return 0.f;
    } else if (ek == E_VT) {
        const float val = v * rstd_of(meta ? e.ssqm_in[col] : e.ssq_in[col]);
        const bf16_t o = (bf16_t)f2bf(val);
        bf16_t* vt = (bf16_t*)(ws + WS_VT);
        if (meta) { for (int b = 0; b < NB; ++b) vt[(size_t)row * VLD + b * LP + MOFF + col] = o; }
        else vt[(size_t)row * VLD + prow_of(col)] = o;
        return 0.f;
    } else if (ek == E_FG) {
        const float xx = v * rstd_of(meta ? e.ssqm_in[col] : e.ssq_in[col]) + e.bfg[row];
        const float lf = fminf(xx, 0.f) - log1pf(expf(-fabsf(xx)));
        float* LF = (float*)(ws + WS_LF);
        if (meta) { for (int b = 0; b < NB; ++b) LF[((size_t)b * NH + row) * LP + MOFF + col] = lf; }
        else LF[((size_t)(col >> 11) * NH + row) * LP + ROFF + (col & 2047)] = lf;
        return 0.f;
    } else if (ek == E_RES) {
        bf16_t* hb = (bf16_t*)(ws + (meta ? WS_HBM : WS_HB));
        float base;
        if (meta) base = e.hmin[(size_t)row * D + col]; else base = e.hin ? e.hin[(size_t)row * D + col] : bf2f(hb[(size_t)row * D + col]);
        const float hn = base + v;
        if (meta) ((float*)(ws + WS_HM))[(size_t)row * D + col] = hn;
        hb[(size_t)row * D + col] = (bf16_t)f2bf(hn);
        return hn * hn;
    } else {
        float t = v * rstd_of(meta ? e.ssqm_in[row] : e.ssq_in[row]); t = fmaxf(t, 0.f); t = t * t;
        bf16_t* u = (bf16_t*)(ws + (meta ? WS_UM : WS_UB)); u[(size_t)row * FF + col] = (bf16_t)f2bf(t);
        return 0.f;
    }
}

enum { JK_NONE = 0, JK_META_IN, JK_FG, JK_FG_META, JK_META_RES, JK_META_UP, JK_NAIVE };
struct SkJob { const bf16_t* X; const bf16_t* Y; int K; int n; int kind; int colofs; int ek; int nNt; int yIsItemN; };

DI void skinny_items(const SkJob& jb, const EpiCtx& e_in, LAS unsigned char* lds, int G, int bid) {
    if (jb.kind == JK_NONE || jb.n <= 0) return;
    int tid = threadIdx.x; asm volatile("" : "+v"(tid));
    const int lane = tid & 63, w = __builtin_amdgcn_readfirstlane(tid >> 6);
    const int K = jb.K, kw = K >> 3;
    LAS f32x4* red = (LAS f32x4*)lds;
    for (int it = bid; it < jb.n; it += G) {
        EpiCtx e = e_in; e.ws = e_in.ws + opaque0();
        int xi = 0, yi = it;
        if (jb.kind == JK_NAIVE) { xi = it / jb.nNt; yi = it % jb.nNt; }
        else if (jb.kind == JK_FG_META) { yi = 0; }
        const bf16_t* xp = jb.X + ((size_t)xi * 16 + (lane & 15)) * K + w * kw + 8 * (lane >> 4);
        const bf16_t* yp = jb.Y + ((size_t)yi * 16 + (lane & 15)) * K + w * kw + 8 * (lane >> 4);
        f32x4 acc = {0.f, 0.f, 0.f, 0.f};
        for (int s = 0; s < kw; s += 256) {
            bf16x8 a[8], b[8];
#pragma unroll
            for (int i = 0; i < 8; ++i) { a[i] = *(const bf16x8*)(xp + s + 32 * i); b[i] = *(const bf16x8*)(yp + s + 32 * i); }
#pragma unroll
            for (int i = 0; i < 8; ++i) acc = __builtin_amdgcn_mfma_f32_16x16x32_bf16(a[i], b[i], acc, 0, 0, 0);
        }
        __syncthreads();
        red[w * 64 + lane] = acc;
        __syncthreads();
        if (w == 0) {
            f32x4 s = red[lane];
#pragma unroll
            for (int i = 1; i < 8; ++i) s += red[i * 64 + lane];
            const int j = lane & 15, i0 = 4 * (lane >> 4);
#pragma unroll
            for (int r = 0; r < 4; ++r) {
                const int i = i0 + r; const float v = s[r];
                float sq = 0.f; bool resm = false; int rrow = 0;
                switch (jb.kind) {
                    case JK_META_IN: { const int n = jb.colofs + it * 16 + j; if (n < 2 * D) epi_elem(e, E_QK, true, i, n, v); else epi_elem(e, E_VT, true, n - 2 * D, i, v); } break;
                    case JK_FG: epi_elem(e, E_FG, false, i, it * 16 + j, v); break;
                    case JK_FG_META: epi_elem(e, E_FG, true, i, j, v); break;
                    case JK_META_RES: sq = epi_elem(e, E_RES, true, i, it * 16 + j, v); resm = true; rrow = i; break;
                    case JK_META_UP: epi_elem(e, E_UP, true, i, it * 16 + j, v); break;
                    default: {
                        const int row = xi * 16 + i, col = yi * 16 + j;
                        sq = epi_elem(e, jb.ek, false, row, col, v); rrow = row; } break;
                }
                if (jb.kind == JK_META_RES || (jb.kind == JK_NAIVE && jb.ek == E_RES)) {
                    sq += __shfl_xor(sq, 1); sq += __shfl_xor(sq, 2); sq += __shfl_xor(sq, 4); sq += __shfl_xor(sq, 8);
                    if (j == 0) __hip_atomic_fetch_add((resm ? e.ssqm_out : e.ssq_out) + rrow, ssq_fix(sq), __ATOMIC_RELAXED, __HIP_MEMORY_SCOPE_AGENT);
                }
            }
        }
    }
    __syncthreads();
}

namespace pg8 {
constexpr int BM = 256, BK = 64, HALF = 128, HTB = HALF * BK * 2, STAGE_BYTES = 8 * HTB, NXCD = 8, WGM = 4;
DI int lds_byte(int r, int c) { const int st = (r >> 4) * 2 + (c >> 5), rr = r & 15, cc = c & 31, ob = rr * 64 + cc * 2; return st * 1024 + (ob ^ (((ob >> 9) & 1) << 5)); }
DI void stage_rc(int b, int& R, int& C) { const int st = b / 1024, sb = b % 1024, swz = sb ^ (((sb >> 9) & 1) << 5); R = (st >> 1) * 16 + swz / 64; C = (st & 1) * 32 + (swz % 64) / 2; }
DI int perm32(int rho) { const int n = rho >> 4, i = rho & 15; return 8 * (i >> 2) + 4 * n + (i & 3); }

struct Unit { const char* a; const char* b; int pm, pn, ek; };
struct Sched {
    const bf16_t *A0, *B0, *A1, *B1; int nM0, nN0, ek0, nM1, nN1, ek1, K, G, c; int ablk;
    int pmmask;
    DI bool next(int i, Unit& u) const {
        int L = i * G + c; const int n0 = nM0 * nN0, n1 = nM1 * nN1;
        const bool second = L >= n0;
        if (second) { L -= n0; if (L >= n1) return false; }
        const bf16_t* A = second ? A1 : A0; const bf16_t* B = second ? B1 : B0;
        const int nM = second ? nM1 : nM0, nN = second ? nN1 : nN0, nwg = nM * nN;
        int wgid = L; { const int q = nwg / NXCD, r = nwg % NXCD, xcd = wgid % NXCD, off = wgid / NXCD; wgid = (xcd < r ? xcd * (q + 1) : r * (q + 1) + (xcd - r) * q) + off; }
        const int nig = WGM * nN, gid = wgid / nig, fm = gid * WGM, gsz = (nM - fm) < WGM ? (nM - fm) : WGM;
        u.pm = fm + ((wgid % nig) % gsz); u.pn = (wgid % nig) / gsz; u.ek = second ? ek1 : ek0;
        const size_t tstep = (size_t)BM * K * 2;
        u.a = (const char*)A + (size_t)(pmmask ? (u.pm & pmmask) : u.pm) * tstep; u.b = (const char*)B + (size_t)u.pn * tstep;
        return true;
    }
};

DI void epilogue(const f32x4 (&acc)[2][2][4][2], const Unit& u, const EpiCtx& e, int wr, int wc, int fr, int fq) {
    unsigned char* ws = e.ws + opaque0();
    const int row0 = u.pm * BM + wr * 64 + fr, col0 = u.pn * BM + wc * 32 + 8 * fq;
    if (u.ek == E_VT) {
        bf16_t* vt = (bf16_t*)(ws + WS_VT);
#pragma unroll
        for (int bj = 0; bj < 2; ++bj) {
            const int tok = col0 + bj * HALF;
            f32x4 r0, r1;
#pragma unroll
            for (int j = 0; j < 4; ++j) { r0[j] = rstd_of(e.ssq_in[tok + j]); r1[j] = rstd_of(e.ssq_in[tok + 4 + j]); }
            const int pc = prow_of(tok);
#pragma unroll
            for (int ai = 0; ai < 2; ++ai)
#pragma unroll
                for (int m = 0; m < 4; ++m) {
                    const int row = row0 + ai * HALF + m * 16;
                    const f32x4 v0 = acc[ai][bj][m][0] * r0, v1 = acc[ai][bj][m][1] * r1;
                    u32x4 w; w.x = pk2(v0[0], v0[1]); w.y = pk2(v0[2], v0[3]); w.z = pk2(v1[0], v1[1]); w.w = pk2(v1[2], v1[3]);
                    *(u32x4*)(vt + (size_t)row * VLD + pc) = w;
                }
        }
        return;
    }
    if (u.ek == E_RES) {
        bf16_t* hb = (bf16_t*)(ws + WS_HB);
#define RES_ROW(V0, V1) do { \
                    const f32x4 v0 = (V0) + acc[ai][bj][m][0] * e.rsc, v1 = (V1) + acc[ai][bj][m][1] * e.rsc; \
                    u32x4 w; w.x = pk2(v0[0], v0[1]); w.y = pk2(v0[2], v0[3]); w.z = pk2(v1[0], v1[1]); w.w = pk2(v1[2], v1[3]); \
                    *(u32x4*)(hb + off) = w; \
                    ss += (v0[0] * v0[0] + v0[1] * v0[1]) + (v0[2] * v0[2] + v0[3] * v0[3]) + (v1[0] * v1[0] + v1[1] * v1[1]) + (v1[2] * v1[2] + v1[3] * v1[3]); } while (0)
#define RES_STAT() do { ss += __shfl_xor(ss, 16); ss += __shfl_xor(ss, 32); \
                    if (fq == 0 && e.rsc != 0.f) __hip_atomic_fetch_add(e.ssq_out + row, ssq_fix(ss), __ATOMIC_RELAXED, __HIP_MEMORY_SCOPE_AGENT); } while (0)
        if (e.hin) {
#pragma unroll
            for (int ai = 0; ai < 2; ++ai) {
                f32x4 r[4][2][2];
#pragma unroll
                for (int m = 0; m < 4; ++m)
#pragma unroll
                    for (int bj = 0; bj < 2; ++bj) { const size_t off = (size_t)(row0 + ai * HALF + m * 16) * D + col0 + bj * HALF; r[m][bj][0] = *(const f32x4*)(e.hin + off); r[m][bj][1] = *(const f32x4*)(e.hin + off + 4); }
#pragma unroll
                for (int m = 0; m < 4; ++m) {
                    const int row = row0 + ai * HALF + m * 16; float ss = 0.f;
#pragma unroll
                    for (int bj = 0; bj < 2; ++bj) { const size_t off = (size_t)row * D + col0 + bj * HALF; RES_ROW(r[m][bj][0], r[m][bj][1]); }
                    RES_STAT();
                }
                asm volatile("" ::: "memory");
            }
        } else {
            u32x4 q[2][4][2];
#pragma unroll
            for (int ai = 0; ai < 2; ++ai)
#pragma unroll
                for (int m = 0; m < 4; ++m)
#pragma unroll
                    for (int bj = 0; bj < 2; ++bj) q[ai][m][bj] = *(const u32x4*)(hb + (size_t)(row0 + ai * HALF + m * 16) * D + col0 + bj * HALF);
#pragma unroll
            for (int ai = 0; ai < 2; ++ai)
#pragma unroll
                for (int m = 0; m < 4; ++m) {
                    const int row = row0 + ai * HALF + m * 16; float ss = 0.f;
#pragma unroll
                    for (int bj = 0; bj < 2; ++bj) {
                        const size_t off = (size_t)row * D + col0 + bj * HALF; const u32x4 t = q[ai][m][bj];
                        const f32x4 a0 = {bflo(t.x), bfhi(t.x), bflo(t.y), bfhi(t.y)}, a1 = {bflo(t.z), bfhi(t.z), bflo(t.w), bfhi(t.w)};
                        RES_ROW(a0, a1);
                    }
                    RES_STAT();
                }
        }
#undef RES_ROW
#undef RES_STAT
        return;
    }
#pragma unroll
    for (int ai = 0; ai < 2; ++ai)
#pragma unroll
        for (int m = 0; m < 4; ++m) {
            const int row = row0 + ai * HALF + m * 16;
            if (u.ek == E_QK) {
                const float rs = rstd_of(e.ssq_in[row]);
#pragma unroll
                for (int bj = 0; bj < 2; ++bj) {
                    const int col = col0 + bj * HALF;
                    const f32x4 v0 = acc[ai][bj][m][0] * rs, v1 = acc[ai][bj][m][1] * rs;
                    u32x4 w; w.x = pk2(v0[0], v0[1]); w.y = pk2(v0[2], v0[3]); w.z = pk2(v1[0], v1[1]); w.w = pk2(v1[2], v1[3]);
                    bf16_t* dst = (col < D) ? (bf16_t*)(ws + WS_QB) + (size_t)row * D + col : (bf16_t*)(ws + WS_KB) + (size_t)prow_of(row) * D + (col - D);
                    *(u32x4*)dst = w;
                }
            } else if (u.ek == E_UP) {
                const float rs = rstd_of(e.ssq_in[row]);
#pragma unroll
                for (int bj = 0; bj < 2; ++bj) {
                    const int col = col0 + bj * HALF;
                    f32x4 v0 = acc[ai][bj][m][0] * rs, v1 = acc[ai][bj][m][1] * rs;
#pragma unroll
                    for (int j = 0; j < 4; ++j) { v0[j] = fmaxf(v0[j], 0.f); v0[j] *= v0[j]; v1[j] = fmaxf(v1[j], 0.f); v1[j] *= v1[j]; }
                    u32x4 w; w.x = pk2(v0[0], v0[1]); w.y = pk2(v0[2], v0[3]); w.z = pk2(v1[0], v1[1]); w.w = pk2(v1[2], v1[3]);
                    *(u32x4*)((bf16_t*)(ws + WS_UB) + ((size_t)(row >> 8) * (FF / 64) + (col >> 6)) * 16384 + (row & 255) * 64 + (col & 63)) = w;
                }
            }
        }
}

DI void gemm_phase(LAS unsigned char* lds, const Sched& S, const EpiCtx& E) {
    int tid = threadIdx.x; asm volatile("" : "+v"(tid));
    const int wid = __builtin_amdgcn_readfirstlane(tid >> 6), lane = tid & 63, wr = wid >> 2, wc = wid & 3, fr = lane & 15, fq = lane >> 4;
    const int K = S.K, nt = K / BK;
    unsigned voffA[2], voffB[2];
#pragma unroll
    for (int i = 0; i < 2; ++i) { int R, C; stage_rc(tid * 16 + i * 8192, R, C); const int Rb = (R & ~31) + perm32(R & 31);
        voffA[i] = (unsigned)(R * (S.ablk ? BK : K) + C) * 2u; voffB[i] = (unsigned)(Rb * K + C) * 2u; }
    const size_t kstep = (size_t)(BK * 2);
    const size_t hstep = (size_t)HALF * K * 2;
    const size_t kstepA = S.ablk ? (size_t)BM * BK * 2 : kstep;
    const size_t hstepA = S.ablk ? (size_t)HALF * BK * 2 : hstep;
    const unsigned ldsw = (unsigned)wid * 1024u;
    const int aoff = lds_byte(wr * 64 + fr, fq * 8), boff = lds_byte(wc * 32 + fr, fq * 8);
#define PG8_SA(b, h) (((b) * 2 + (h)) * HTB)
#define PG8_SB(b, h) ((4 + (b) * 2 + (h)) * HTB)
#define PG8_STAGE(bufoff, gbase, voff) do { _Pragma("unroll") for (int _i = 0; _i < 2; ++_i) \
        __builtin_amdgcn_global_load_lds((const unsigned*)((const char*)(gbase) + (voff)[_i]), (LAS unsigned*)(lds + (bufoff) + ldsw + _i * 8192), 16, 0, 0); } while (0)
#define PG8_LDA(dst, b, h) do { _Pragma("unroll") for (int m = 0; m < 4; ++m) _Pragma("unroll") for (int k = 0; k < 2; ++k) dst[m][k] = *(const LAS bf16x8*)(lds + PG8_SA(b, h) + aoff + m * 2048 + k * 1024); } while (0)
#define PG8_LDB(dst, b, h) do { _Pragma("unroll") for (int n = 0; n < 2; ++n) _Pragma("unroll") for (int k = 0; k < 2; ++k) dst[n][k] = *(const LAS bf16x8*)(lds + PG8_SB(b, h) + boff + n * 2048 + k * 1024); } while (0)
#define PG8_MMA(ai, bj, At, Bt) do { __builtin_amdgcn_s_setprio(1); _Pragma("unroll") for (int m = 0; m < 4; ++m) _Pragma("unroll") for (int n = 0; n < 2; ++n) _Pragma("unroll") for (int k = 0; k < 2; ++k) \
        acc[ai][bj][m][n] = __builtin_amdgcn_mfma_f32_16x16x32_bf16(Bt[n][k], At[m][k], acc[ai][bj][m][n], 0, 0, 0); __builtin_amdgcn_s_setprio(0); } while (0)
#define PG8_WAIT_V(n) asm volatile("s_waitcnt vmcnt(" #n ")" ::: "memory")
#define PG8_WAIT_L(n) asm volatile("s_waitcnt lgkmcnt(" #n ")" ::: "memory")
#define PG8_BAR __builtin_amdgcn_s_barrier()
#define PG8_SCHED __builtin_amdgcn_sched_barrier(0)
    Unit cur, nxt; int ui = 0;
    if (!S.next(0, cur)) return;
    f32x4 acc[2][2][4][2];
#pragma unroll
    for (int a = 0; a < 2; ++a)
#pragma unroll
        for (int b = 0; b < 2; ++b)
#pragma unroll
            for (int m = 0; m < 4; ++m)
#pragma unroll
                for (int n = 0; n < 2; ++n) acc[a][b][m][n] = (f32x4){0.f, 0.f, 0.f, 0.f};
    bf16x8 At[4][2], B0[2][2], B1[2][2];
    const char* cA = cur.a; const char* cB = cur.b;
#if GEMM_SP2
    PG8_STAGE(PG8_SB(0, 0), cB, voffB); PG8_STAGE(PG8_SB(0, 1), cB + hstep, voffB); PG8_STAGE(PG8_SA(0, 0), cA, voffA); PG8_STAGE(PG8_SA(0, 1), cA + hstepA, voffA);
    if (wr == 1) PG8_BAR;
    PG8_WAIT_V(2); PG8_BAR;
    PG8_STAGE(PG8_SB(1, 0), cB + kstep, voffB); PG8_STAGE(PG8_SA(1, 0), cA + kstepA, voffA); PG8_STAGE(PG8_SB(1, 1), cB + hstep + kstep, voffB);
    PG8_WAIT_V(6); PG8_BAR;
#else
    PG8_STAGE(PG8_SB(0, 0), cB, voffB); PG8_STAGE(PG8_SA(0, 0), cA, voffA); PG8_STAGE(PG8_SB(0, 1), cB + hstep, voffB); PG8_STAGE(PG8_SA(0, 1), cA + hstepA, voffA);
    if (wr == 1) PG8_BAR;
    PG8_WAIT_V(4); PG8_BAR;
    PG8_STAGE(PG8_SB(1, 0), cB + kstep, voffB); PG8_STAGE(PG8_SA(1, 0), cA + kstepA, voffA); PG8_STAGE(PG8_SB(1, 1), cB + hstep + kstep, voffB);
    PG8_WAIT_V(6); PG8_BAR;
#endif
    for (;;) {
        const bool has_next = S.next(ui + 1, nxt);
        const char* nA = has_next ? nxt.a : cA; const char* nB = has_next ? nxt.b : cB;
        for (int t = 0; t < nt; t += 2) {
            const bool last = (t == nt - 2);
            const char* a1 = cA + (size_t)(t + 1) * kstepA;
            const char* a2 = last ? nA : cA + (size_t)(t + 2) * kstepA; const char* b2 = last ? nB : cB + (size_t)(t + 2) * kstep;
            const char* a3 = a2 + kstepA; const char* b3 = b2 + kstep;
#if GEMM_SP2
            PG8_LDB(B0, 0, 0); PG8_LDB(B1, 0, 1); PG8_SCHED; PG8_LDA(At, 0, 0); PG8_STAGE(PG8_SA(1, 1), a1 + hstepA, voffA);
            PG8_WAIT_V(8); PG8_WAIT_L(0); PG8_BAR; PG8_MMA(0, 0, At, B0); PG8_MMA(0, 1, At, B1); PG8_BAR; PG8_SCHED;
            PG8_LDA(At, 0, 1); PG8_STAGE(PG8_SB(0, 0), b2, voffB); PG8_STAGE(PG8_SB(0, 1), b2 + hstep, voffB); PG8_STAGE(PG8_SA(0, 0), a2, voffA);
            PG8_WAIT_V(8); PG8_WAIT_L(0); PG8_BAR; PG8_MMA(1, 0, At, B0); PG8_MMA(1, 1, At, B1); PG8_BAR; PG8_SCHED;
            PG8_LDB(B0, 1, 0); PG8_LDB(B1, 1, 1); PG8_SCHED; PG8_LDA(At, 1, 0); PG8_STAGE(PG8_SA(0, 1), a2 + hstepA, voffA);
            PG8_WAIT_V(8); PG8_WAIT_L(0); PG8_BAR; PG8_MMA(0, 0, At, B0); PG8_MMA(0, 1, At, B1); PG8_BAR; PG8_SCHED;
            PG8_LDA(At, 1, 1); PG8_STAGE(PG8_SB(1, 0), b3, voffB); PG8_STAGE(PG8_SB(1, 1), b3 + hstep, voffB); PG8_STAGE(PG8_SA(1, 0), a3, voffA);
            PG8_WAIT_V(8); PG8_WAIT_L(0); PG8_BAR; PG8_MMA(1, 0, At, B0); PG8_MMA(1, 1, At, B1); PG8_BAR; PG8_SCHED;
#else
            PG8_LDB(B0, 0, 0); PG8_SCHED; PG8_LDA(At, 0, 0); PG8_STAGE(PG8_SA(1, 1), a1 + hstepA, voffA);
            PG8_WAIT_L(8); PG8_BAR; PG8_WAIT_L(0); PG8_MMA(0, 0, At, B0); PG8_BAR; PG8_SCHED;
            PG8_LDB(B1, 0, 1); PG8_STAGE(PG8_SB(0, 0), b2, voffB);
            PG8_BAR; PG8_WAIT_L(0); PG8_MMA(0, 1, At, B1); PG8_BAR;
            PG8_LDA(At, 0, 1); PG8_STAGE(PG8_SA(0, 0), a2, voffA);
            PG8_BAR; PG8_WAIT_L(0); PG8_MMA(1, 0, At, B0); PG8_BAR; PG8_SCHED;
            PG8_STAGE(PG8_SB(0, 1), b2 + hstep, voffB);
            PG8_WAIT_V(6); PG8_BAR; PG8_MMA(1, 1, At, B1); PG8_BAR;
            PG8_LDB(B0, 1, 0); PG8_SCHED; PG8_LDA(At, 1, 0); PG8_STAGE(PG8_SA(0, 1), a2 + hstepA, voffA);
            PG8_WAIT_L(8); PG8_BAR; PG8_WAIT_L(0); PG8_MMA(0, 0, At, B0); PG8_BAR; PG8_SCHED;
            PG8_LDB(B1, 1, 1); PG8_STAGE(PG8_SB(1, 0), b3, voffB);
            PG8_BAR; PG8_WAIT_L(0); PG8_MMA(0, 1, At, B1); PG8_BAR;
            PG8_LDA(At, 1, 1); PG8_STAGE(PG8_SA(1, 0), a3, voffA);
            PG8_BAR; PG8_WAIT_L(0); PG8_MMA(1, 0, At, B0); PG8_BAR; PG8_SCHED;
            PG8_STAGE(PG8_SB(1, 1), b3 + hstep, voffB);
            PG8_WAIT_V(6); PG8_BAR; PG8_MMA(1, 1, At, B1); PG8_BAR;
        #endif
        }
#if GEMM_SP2
        if (wr == 0) PG8_BAR;
#endif
        epilogue(acc, cur, E, wr, wc, fr, fq);
        if (!has_next) break;
#pragma unroll
        for (int a = 0; a < 2; ++a)
#pragma unroll
            for (int b = 0; b < 2; ++b)
#pragma unroll
                for (int m = 0; m < 4; ++m)
#pragma unroll
                    for (int n = 0; n < 2; ++n) acc[a][b][m][n] = (f32x4){0.f, 0.f, 0.f, 0.f};
        cur = nxt; cA = nA; cB = nB; ++ui;
#if GEMM_SP2
        if (wr == 1) PG8_BAR;
#endif
    }
    PG8_WAIT_V(0);
#if !GEMM_SP2
    if (wr == 0) PG8_BAR;
#endif
    PG8_BAR;
#undef PG8_SA
#undef PG8_SB
#undef PG8_STAGE
#undef PG8_LDA
#undef PG8_LDB
#undef PG8_MMA
#undef PG8_WAIT_V
#undef PG8_WAIT_L
#undef PG8_BAR
#undef PG8_SCHED
}
}

struct CvJob { const float* src; int ld, K, N; bf16_t* dst; const float* g; int qs; };
constexpr int CT_IN = 16 * 96, CT_O = 16 * 32, CT_UP = 16 * 128, CT_DN = 64 * 32, CT_KV = 16 * 64;
constexpr int CT_TOTAL = 2 * CT_IN + 2 * CT_O + 4 * CT_UP + 4 * CT_DN + CT_O + CT_KV + CT_O + 2 * CT_O;
DI CvJob cv_job(const Params& P, int t, int& local) {
    unsigned char* ws = P.ws; CvJob j;
    if (t < 2 * CT_IN) { const int l = t / CT_IN; local = t % CT_IN; j = {P.fox_w_in + (size_t)l * D * NIN, NIN, D, 3 * D, (bf16_t*)(ws + WS_WT_IN) + (size_t)l * 3 * D * D, P.norm_attn + l * D, D}; return j; } t -= 2 * CT_IN;
    if (t < 2 * CT_O) { const int l = t / CT_O; local = t % CT_O; j = {P.fox_w_o + (size_t)l * D * D, D, D, D, (bf16_t*)(ws + WS_WT_O) + (size_t)l * D * D, nullptr, 0}; return j; } t -= 2 * CT_O;
    if (t < 4 * CT_UP) { const int l = t / CT_UP; local = t % CT_UP; j = {P.w_up + (size_t)l * D * FF, FF, D, FF, (bf16_t*)(ws + WS_WT_UP) + (size_t)l * FF * D, P.norm_mlp + l * D, 0}; return j; } t -= 4 * CT_UP;
    if (t < 4 * CT_DN) { const int l = t / CT_DN; local = t % CT_DN; j = {P.w_down + (size_t)l * FF * D, D, FF, D, (bf16_t*)(ws + WS_WT_DN) + (size_t)l * D * FF, nullptr, 0}; return j; } t -= 4 * CT_DN;
    if (t < CT_O) { local = t; j = {P.sb_w_q, D, D, D, (bf16_t*)(ws + WS_WT_QKV2), P.norm_attn + 2 * D, D}; return j; } t -= CT_O;
    if (t < CT_KV) { local = t; j = {P.w_kv, 2 * D, D, 2 * D, (bf16_t*)(ws + WS_WT_QKV2) + (size_t)D * D, P.kv_norm, 0}; return j; } t -= CT_KV;
    if (t < CT_O) { local = t; j = {P.sb_w_q + (size_t)D * D, D, D, D, (bf16_t*)(ws + WS_WT_Q3), P.norm_attn + 3 * D, D}; return j; } t -= CT_O;
    { const int l = t / CT_O; local = t % CT_O; j = {P.sb_w_o + (size_t)l * D * D, D, D, D, (bf16_t*)(ws + WS_WT_SO) + (size_t)l * D * D, nullptr, 0}; return j; }
}

DI void phase0(const Params& P, LAS unsigned char* lds, int G, int bid) {
    int tid = threadIdx.x; asm volatile("" : "+v"(tid));
    const int lane = tid & 63, w = tid >> 6;
    unsigned char* ws = P.ws;
    {
        u64* ssq = (u64*)(ws + WS_SSQ);
        for (int i = bid * NTHR + tid; i < 8 * MR; i += G * NTHR) ssq[MR + i] = 0ull;
        u64* ssqm = (u64*)(ws + WS_SSQM);
        if (bid == 0 && tid < 8 * 16) ssqm[16 + tid] = 0ull;
        u32x4 z = {0u, 0u, 0u, 0u};
        for (int i = bid * NTHR + tid; i < NB * 12288; i += G * NTHR) { const int b = i / 12288, r = i % 12288; *(u32x4*)(ws + WS_KB + (size_t)b * LP * D * 2 + (size_t)r * 16) = z; }
        for (int i = bid * NTHR + tid; i < D * NB * 6; i += G * NTHR) { const int d = i / (NB * 6), r = i % (NB * 6), b = r / 6, c = r % 6; *(u32x4*)(ws + WS_VT + ((size_t)d * VLD + b * LP) * 2 + c * 16) = z; }
    }
    {
        bf16_t* wf = (bf16_t*)(ws + WS_WF);
        for (int i = bid * NTHR + tid; i < 2 * 16 * D; i += G * NTHR) {
            const int l = i / (16 * D), r = i % (16 * D), k = r / 16, hd = r % 16;
            wf[(size_t)l * 16 * D + (size_t)hd * D + k] = (bf16_t)f2bf(P.norm_attn[l * D + k] * P.fox_w_in[(size_t)l * D * NIN + (size_t)k * NIN + 3 * D + hd]);
        }
    }
    {
        u64* ssq = (u64*)(ws + WS_SSQ); u64* ssqm = (u64*)(ws + WS_SSQM);
        for (int r = bid * 8 + w; r < MR + NMETA; r += G * 8) {
            const bool meta = r >= MR; const int rr = meta ? r - MR : r;
            const f32x4* src = (const f32x4*)((meta ? P.meta : P.x) + (size_t)rr * D) + lane;
            u32x2* dst = (u32x2*)(ws + (meta ? WS_HBM : WS_HB) + (size_t)rr * D * 2) + lane;
            float s = 0.f;
#pragma unroll
            for (int j = 0; j < 8; ++j) { const f32x4 v = src[64 * j]; s += (v[0] * v[0] + v[1] * v[1]) + (v[2] * v[2] + v[3] * v[3]); u32x2 o; o.x = pk2(v[0], v[1]); o.y = pk2(v[2], v[3]); dst[64 * j] = o; }
            s = wave_sum(s);
            if (lane == 0) { if (meta) ssqm[rr] = ssq_fix(s); else ssq[rr] = ssq_fix(s); }
        }
    }
    {
        LAS unsigned* T = (LAS unsigned*)lds;
        f32x4 ra[2][2], rb[2][2];
        bf16_t *da = nullptr, *db = nullptr; const float *ga = nullptr, *gb = nullptr; int Ka = 0, Kb = 0; bool sa = false, sb = false;
#define CV_LOAD(R, DST, GP, KD, SC, tt) do { int local_; const CvJob j_ = cv_job(P, (tt), local_); \
            const int nnt_ = j_.N / 64, k0_ = (local_ / nnt_) * 128, n0_ = (local_ % nnt_) * 64; \
            _Pragma("unroll") for (int p = 0; p < 2; ++p) { const int idx = tid + NTHR * p, kp = idx >> 4, nq = idx & 15; \
                const float* s_ = j_.src + (size_t)(k0_ + 2 * kp) * j_.ld + n0_ + 4 * nq; \
                R[p][0] = __builtin_nontemporal_load((const f32x4*)s_); R[p][1] = __builtin_nontemporal_load((const f32x4*)(s_ + j_.ld)); } \
            DST = j_.dst + (size_t)n0_ * j_.K + k0_; GP = j_.g ? j_.g + k0_ : nullptr; KD = j_.K; SC = n0_ < j_.qs; } while (0)
#define CV_CONVERT(R, GP, SC) do { _Pragma("unroll") for (int p = 0; p < 2; ++p) { const int idx = tid + NTHR * p, kp = idx >> 4, nq = idx & 15; \
                float g0 = 1.f, g1 = 1.f; if (GP) { g0 = GP[2 * kp]; g1 = GP[2 * kp + 1]; } \
                if (SC) { g0 *= QSCALE; g1 *= QSCALE; } \
                _Pragma("unroll") for (int i = 0; i < 4; ++i) T[(4 * nq + i) * 65 + kp] = pk2(R[p][0][i] * g0, R[p][1][i] * g1); } } while (0)
#define CV_STORE(DST, KD) do { _Pragma("unroll") for (int p = 0; p < 2; ++p) { const int idx = tid + NTHR * p, n = idx >> 4, kq = idx & 15; \
                u32x4 o; o.x = T[n * 65 + 4 * kq]; o.y = T[n * 65 + 4 * kq + 1]; o.z = T[n * 65 + 4 * kq + 2]; o.w = T[n * 65 + 4 * kq + 3]; \
                *(u32x4*)(DST + (size_t)n * KD + 8 * kq) = o; } } while (0)
        int t = bid;
        if (t < CT_TOTAL) CV_LOAD(ra, da, ga, Ka, sa, t);
        if (t + G < CT_TOTAL) CV_LOAD(rb, db, gb, Kb, sb, t + G);
        while (t < CT_TOTAL) {
            { bf16_t* cd = da; const int ck = Ka;
              CV_CONVERT(ra, ga, sa);
              if (t + 2 * G < CT_TOTAL) CV_LOAD(ra, da, ga, Ka, sa, t + 2 * G);
              __syncthreads();
              CV_STORE(cd, ck);
              __syncthreads(); }
            if (t + G >= CT_TOTAL) break;
            { bf16_t* cd = db; const int ck = Kb;
              CV_CONVERT(rb, gb, sb);
              if (t + 3 * G < CT_TOTAL) CV_LOAD(rb, db, gb, Kb, sb, t + 3 * G);
              __syncthreads();
              CV_STORE(cd, ck);
              __syncthreads(); }
            t += 2 * G;
        }
#undef CV_LOAD
#undef CV_CONVERT
#undef CV_STORE
    }
}

DI void compute_c2(const float* LF, int b, int h, LAS float* c2, LAS float* wtot) {
    int tid = threadIdx.x; asm volatile("" : "+v"(tid));
    const int lane = tid & 63, w = tid >> 6;
    const float* src = LF + ((size_t)b * NH + h) * LP;
    const int cbeg = w * 264, cend = cbeg + 264, p0 = cbeg + lane * 5;
    float v[5]; float run = 0.f;
#pragma unroll
    for (int e = 0; e < 5; ++e) { const int pos = p0 + e; const float x = (pos >= MOFF && pos < cend) ? src[pos] : 0.f; run += x; v[e] = run; }
    float incl = run;
#pragma unroll
    for (int o = 1; o < 64; o <<= 1) { const float t = __shfl_up(incl, o); if (lane >= o) incl += t; }
    const float excl = incl - run;
    if (lane == 63) wtot[w] = incl;
    __syncthreads();
    float wp = 0.f;
    for (int i = 0; i < w; ++i) wp += wtot[i];
#pragma unroll
    for (int e = 0; e < 5; ++e) { const int pos = p0 + e; if (pos < cend) c2[pos] = (pos < MOFF) ? __builtin_inff() : (wp + excl + v[e]) * LOG2E; }
    __syncthreads();
}

template <int TYPE>
DI void naive_attn_row(const unsigned char* ws, int b, int h, const bf16_t* qptr, int qpos, bf16_t* optr, const LAS float* c2, LAS float* sc, LAS float* qf) {
    int tid_ = threadIdx.x; asm volatile("" : "+v"(tid_));
    const int lane = tid_ & 63;
    const bf16_t* KB = (const bf16_t*)(ws + WS_KB); const bf16_t* VT = (const bf16_t*)(ws + WS_VT);
    { const unsigned qq = *(const unsigned*)(qptr + 2 * lane); qf[2 * lane] = bflo(qq); qf[2 * lane + 1] = bfhi(qq); }
    lds_fence();
    const int nkeys = (TYPE == 0) ? (qpos - MOFF + 1) : (qpos - MOFF);
    const int nk8 = (nkeys + 7) & ~7;
    for (int j = lane; j < nk8; j += 64) {
        float dot = 0.f;
        if (j < nkeys) {
            const u32x4* kp = (const u32x4*)(KB + ((size_t)b * LP + MOFF + j) * D + h * DH);
#pragma unroll 4
            for (int c = 0; c < 16; ++c) { const u32x4 kv = kp[c]; const f32x4 q0 = *(const LAS f32x4*)(qf + 8 * c), q1 = *(const LAS f32x4*)(qf + 8 * c + 4);
                dot += bflo(kv.x) * q0[0] + bfhi(kv.x) * q0[1] + bflo(kv.y) * q0[2] + bfhi(kv.y) * q0[3] + bflo(kv.z) * q1[0] + bfhi(kv.z) * q1[1] + bflo(kv.w) * q1[2] + bfhi(kv.w) * q1[3]; }
        }
        sc[j] = dot;
    }
    lds_fence();
    float inv = 1.f;
    if (TYPE == 0) {
        float m = -__builtin_inff();
        for (int j = lane; j < nkeys; j += 64) m = fmaxf(m, sc[j] - c2[MOFF + j]);
        m = wave_max(m);
        float l = 0.f;
        for (int j = lane; j < nk8; j += 64) { const float p = (j < nkeys) ? ex2(sc[j] - c2[MOFF + j] - m) : 0.f; l += p; sc[j] = p; }
        l = wave_sum(l); inv = 1.f / l;
    } else {
        float carry = 0.f;
        for (int top = nk8 - 1; top >= 0; top -= 64) {
            const int j = top - lane; const bool valid = (j >= 0) && (j < nkeys);
            const float y = (j >= 0) ? sc[j] : 0.f;
            const float sp = fmaxf(y, 0.f) + lg2(1.f + ex2(-fabsf(y)));
            const float lom = valid ? -sp : 0.f;
            float incl = lom;
#pragma unroll
            for (int o = 1; o < 64; o <<= 1) { const float t = __shfl_up(incl, o); if (lane >= o) incl += t; }
            const float a = valid ? ex2(y - sp + carry + (incl - lom)) : 0.f;
            if (j >= 0) sc[j] = a;
            carry += __shfl(incl, 63);
        }
    }
    lds_fence();
    float o0 = 0.f, o1 = 0.f;
    const bf16_t* v0 = VT + (size_t)(h * DH + 2 * lane) * VLD + b * LP + MOFF; const bf16_t* v1 = v0 + VLD;
#pragma unroll 2
    for (int j = 0; j < nk8; j += 8) {
        const u32x4 a = *(const u32x4*)(v0 + j), c = *(const u32x4*)(v1 + j);
        const f32x4 p0 = *(const LAS f32x4*)(sc + j), p1 = *(const LAS f32x4*)(sc + j + 4);
        o0 += bflo(a.x) * p0[0] + bfhi(a.x) * p0[1] + bflo(a.y) * p0[2] + bfhi(a.y) * p0[3] + bflo(a.z) * p1[0] + bfhi(a.z) * p1[1] + bflo(a.w) * p1[2] + bfhi(a.w) * p1[3];
        o1 += bflo(c.x) * p0[0] + bfhi(c.x) * p0[1] + bflo(c.y) * p0[2] + bfhi(c.y) * p0[3] + bflo(c.z) * p1[0] + bfhi(c.z) * p1[1] + bflo(c.w) * p1[2] + bfhi(c.w) * p1[3];
    }
    *(unsigned*)(optr + 2 * lane) = pk2(o0 * inv, o1 * inv);
    lds_fence();
}

constexpr int AT_C2 = 0, AT_WTOT = 8448, AT_K0 = 8704, AT_KSZ = 64 * 272, AT_V0 = AT_K0 + 2 * AT_KSZ, AT_VSZ = 128 * 144;
constexpr int NA_SC = 8704, NA_QF = NA_SC + 8 * 2064 * 4;
static_assert(AT_V0 + 3 * AT_VSZ <= 131072 && NA_QF + 8 * 128 * 4 <= 131072, "attention LDS");

DI int swap23(int m) { return (m & 0x13) | ((m & 4) << 1) | ((m & 8) >> 1); }

template <int TYPE>
DI void attn_item(const unsigned char* ws_in, LAS unsigned char* lds, int b, int h, int qb) {
    const unsigned char* ws = ws_in + opaque0();
    int tid = threadIdx.x; asm volatile("" : "+v"(tid));
    const int lane = tid & 63, w = __builtin_amdgcn_readfirstlane(tid >> 6), m32 = lane & 31, g = lane >> 5;
    const bf16_t* QB = (const bf16_t*)(ws + WS_QB); const bf16_t* KB = (const bf16_t*)(ws + WS_KB); const bf16_t* VT = (const bf16_t*)(ws + WS_VT);
    bf16_t* OB = (bf16_t*)(ws + WS_OB);
    const LAS float* c2 = (const LAS float*)(lds + AT_C2);
    const int nkt = 4 * qb + 5;
    const int prow0 = ROFF + 256 * qb + 32 * w, plast = prow0 + 31, qp = prow0 + m32;
    const int tok = b * SEQ + 256 * qb + 32 * w + m32;
    bf16x8 Q[8];
    { const bf16_t* qptr = QB + (size_t)tok * D + h * DH + 8 * g;
#pragma unroll
      for (int ks = 0; ks < 8; ++ks) Q[ks] = *(const bf16x8*)(qptr + 16 * ks); }
    f32x16 O[4];
#pragma unroll
    for (int i = 0; i < 4; ++i)
#pragma unroll
        for (int a = 0; a < 16; ++a) O[i][a] = 0.f;
    float mrun = -__builtin_inff(), lrun = 0.f, carry = 1.f;
    u32x4 kreg[2], vreg[2];
    const bf16_t* kbase = KB + (size_t)b * LP * D + h * DH;
    const bf16_t* vbase = VT + (size_t)h * DH * VLD + b * LP;
#define AT_LOAD(kt) do { _Pragma("unroll") for (int i = 0; i < 2; ++i) { const int ch = tid + NTHR * i; \
        kreg[i] = *(const u32x4*)(kbase + (size_t)(64 * (kt) + (ch >> 4)) * D + 8 * (ch & 15)); \
        vreg[i] = *(const u32x4*)(vbase + (size_t)(ch >> 3) * VLD + 64 * (kt) + 8 * (ch & 7)); } } while (0)
#define AT_STORE(kbuf, vbuf) do { _Pragma("unroll") for (int i = 0; i < 2; ++i) { const int ch = tid + NTHR * i; \
        *(LAS u32x4*)(lds + AT_K0 + (kbuf) * AT_KSZ + (ch >> 4) * 272 + (ch & 15) * 16) = kreg[i]; \
        *(LAS u32x4*)(lds + AT_V0 + (vbuf) * AT_VSZ + (ch >> 3) * 144 + (ch & 7) * 16) = vreg[i]; } } while (0)
#define AT_PV(vbuf) do { const LAS unsigned char* vb_ = lds + AT_V0 + (vbuf) * AT_VSZ; \
        _Pragma("unroll") for (int db = 0; db < 4; ++db) _Pragma("unroll") for (int blk = 0; blk < 2; ++blk) _Pragma("unroll") for (int s = 0; s < 2; ++s) { \
            const bf16x8 vf = *(const LAS bf16x8*)(vb_ + (32 * db + m32) * 144 + 64 * blk + 32 * s + 16 * g); \
            O[db] = __builtin_amdgcn_mfma_f32_32x32x16_bf16(vf, Pf[blk][s], O[db], 0, 0, 0); } } while (0)
    __syncthreads();
    if (TYPE == 1 && tid < 3) ((volatile LAS unsigned*)(lds + AT_WTOT))[tid] = 0u;
    { const int kt0 = (TYPE == 0) ? 0 : nkt - 1; AT_LOAD(kt0); AT_STORE(0, 0); }
    __syncthreads();
    const int krow = swap23(m32);
    const bool grpB = (w >= 4);
    bf16x8 Pf[2][2];
    bool pend = false; int vprev = 0, vcur = 0;
    volatile LAS unsigned* dcnt = (volatile LAS unsigned*)(lds + AT_WTOT);
    bool wdone = false; int dc = 0;
    for (int it = 0; it <= nkt; ++it) {
        if (TYPE == 1) {
            const int dn = (dc == 2) ? 0 : dc + 1, dz = (dn == 2) ? 0 : dn + 1;
            if (dcnt[dc] == 8u) { if (pend) { AT_PV(vprev); pend = false; } break; }
            if (tid == 0) dcnt[dz] = 0u;
            if (wdone && lane == 0) __hip_atomic_fetch_add((LAS unsigned*)(lds + AT_WTOT) + dn, 1u, __ATOMIC_RELAXED, __HIP_MEMORY_SCOPE_WORKGROUP);
            dc = dn;
        }
        const bool have = it < nkt;
        const int kt = (TYPE == 0) ? it : nkt - 1 - it, cur = it & 1;
        const bool more = it + 1 < nkt;
        const int vnext = (vcur == 2) ? 0 : vcur + 1;
        if (more) { const int ktn = (TYPE == 0) ? it + 1 : nkt - 2 - it; AT_LOAD(ktn); }
        if (pend) { AT_PV(vprev); pend = false; }
        if (have && 64 * kt <= plast && !wdone) {
            const LAS unsigned char* kb = lds + AT_K0 + cur * AT_KSZ;
            f32x16 S[2];
#pragma unroll
            for (int blk = 0; blk < 2; ++blk) {
                if (TYPE == 0) {
#pragma unroll
                    for (int s = 0; s < 2; ++s) { const int kp0 = 64 * kt + 32 * blk + 16 * s + 8 * g;
                        const f32x4 ca = *(const LAS f32x4*)(c2 + kp0), cb = *(const LAS f32x4*)(c2 + kp0 + 4);
#pragma unroll
                        for (int e = 0; e < 4; ++e) { S[blk][8 * s + e] = -ca[e]; S[blk][8 * s + 4 + e] = -cb[e]; } }
                } else {
#pragma unroll
                    for (int a = 0; a < 16; ++a) S[blk][a] = 0.f;
                }
#pragma unroll
                for (int ks = 0; ks < 8; ++ks) {
                    const bf16x8 kf = *(const LAS bf16x8*)(kb + (32 * blk + krow) * 272 + 32 * ks + 16 * g);
                    S[blk] = __builtin_amdgcn_mfma_f32_32x32x16_bf16(kf, Q[ks], S[blk], 0, 0, 0);
                }
            }
            const bool diag = (64 * kt + 63 >= prow0);
            if (TYPE == 0) {
                float mx = -__builtin_inff();
#define FOX_SCORE(MASKED) _Pragma("unroll") for (int blk = 0; blk < 2; ++blk) _Pragma("unroll") for (int s = 0; s < 2; ++s) { \
                        const int kp0 = 64 * kt + 32 * blk + 16 * s + 8 * g; \
                        _Pragma("unroll") for (int e = 0; e < 8; ++e) { \
                            float sv = S[blk][8 * s + e]; \
                            if (MASKED) { if (kp0 + e > qp) sv = -__builtin_inff(); } \
                            S[blk][8 * s + e] = sv; mx = fmaxf(mx, sv); } }
                if (diag) { FOX_SCORE(true) } else { FOX_SCORE(false) }
#undef FOX_SCORE
                mx = fmaxf(mx, xor32(mx, lane));
                const float mnew = fmaxf(mrun, mx);
                const float alpha = ex2(mrun - mnew);
                mrun = mnew;
                float rs = 0.f;
#pragma unroll
                for (int blk = 0; blk < 2; ++blk)
#pragma unroll
                    for (int s = 0; s < 2; ++s) {
                        float p[8];
#pragma unroll
                        for (int e = 0; e < 8; ++e) { p[e] = ex2(S[blk][8 * s + e] - mnew); rs += p[e]; }
                        u32x4 pw; pw.x = pk2(p[0], p[1]); pw.y = pk2(p[2], p[3]); pw.z = pk2(p[4], p[5]); pw.w = pk2(p[6], p[7]);
                        Pf[blk][s] = __builtin_bit_cast(bf16x8, pw);
                    }
                lrun = lrun * alpha + rs;
                if (__builtin_amdgcn_ballot_w64(alpha != 1.0f) != 0ull) {
#pragma unroll
                    for (int i = 0; i < 4; ++i)
#pragma unroll
                        for (int a = 0; a < 16; ++a) O[i][a] *= alpha;
                }
            } else {
                float T[2][2];
                const unsigned qlim = (unsigned)(qp - MOFF);
                const bool msk = diag || kt == 0;
#pragma unroll
                for (int blk = 0; blk < 2; ++blk)
#pragma unroll
                    for (int s = 0; s < 2; ++s) {
                        const int kp0 = 64 * kt + 32 * blk + 16 * s + 8 * g;
                        float run = 1.f;
#pragma unroll
                        for (int e = 7; e >= 0; --e) {
                            float y = S[blk][8 * s + e];
                            if (msk) y = ((unsigned)(kp0 + e - MOFF) < qlim) ? y : -126.f;
                            const float t = ex2(-fmaxf(y, -126.f));
                            const float beta = __builtin_amdgcn_rcpf(1.f + t), omb = t * beta;
                            S[blk][8 * s + e] = beta * run; run *= omb;
                        }
                        T[blk][s] = run;
                    }
                float PT[2][2];
#pragma unroll
                for (int blk = 0; blk < 2; ++blk)
#pragma unroll
                    for (int s = 0; s < 2; ++s) PT[blk][s] = xor32(T[blk][s], lane);
                float off[2][2]; float accu = carry;
#pragma unroll
                for (int blk = 1; blk >= 0; --blk)
#pragma unroll
                    for (int s = 1; s >= 0; --s) { off[blk][s] = (g == 0) ? accu * PT[blk][s] : accu; accu *= T[blk][s] * PT[blk][s]; }
                carry = accu;
                if (__builtin_amdgcn_ballot_w64(carry >= 7.888609e-31f) == 0ull) { wdone = true;
                    if (lane == 0) __hip_atomic_fetch_add((LAS unsigned*)(lds + AT_WTOT) + dc, 1u, __ATOMIC_RELAXED, __HIP_MEMORY_SCOPE_WORKGROUP); }
#pragma unroll
                for (int blk = 0; blk < 2; ++blk)
#pragma unroll
                    for (int s = 0; s < 2; ++s) {
                        float p[8];
#pragma unroll
                        for (int e = 0; e < 8; ++e) p[e] = S[blk][8 * s + e] * off[blk][s];
                        u32x4 pw; pw.x = pk2(p[0], p[1]); pw.y = pk2(p[2], p[3]); pw.z = pk2(p[4], p[5]); pw.w = pk2(p[6], p[7]);
                        Pf[blk][s] = __builtin_bit_cast(bf16x8, pw);
                    }
            }
            if (grpB) { pend = true; vprev = vcur; } else { AT_PV(vcur); }
        }
        if (more) AT_STORE(cur ^ 1, vnext);
        __syncthreads();
        vcur = vnext;
    }
#undef AT_LOAD
#undef AT_STORE
#undef AT_PV
    float inv = 1.f;
    if (TYPE == 0) { const float lt = lrun + xor32(lrun, lane); inv = 1.f / lt; }
    bf16_t* op = OB + (size_t)tok * D + h * DH + 8 * g;
#pragma unroll
    for (int db = 0; db < 4; ++db)
#pragma unroll
        for (int j = 0; j < 2; ++j) {
            const unsigned ax = pk2(O[db][8 * j] * inv, O[db][8 * j + 1] * inv), ay = pk2(O[db][8 * j + 2] * inv, O[db][8 * j + 3] * inv);
            const unsigned bx = pk2(O[db][8 * j + 4] * inv, O[db][8 * j + 5] * inv), by = pk2(O[db][8 * j + 6] * inv, O[db][8 * j + 7] * inv);
            const auto rx = __builtin_amdgcn_permlane32_swap(ax, bx, false, false), ry = __builtin_amdgcn_permlane32_swap(ay, by, false, false);
            u32x4 o; o.x = rx[0]; o.y = ry[0]; o.z = rx[1]; o.w = ry[1];
            *(u32x4*)(op + 32 * db + 16 * j) = o;
        }
}

DI void attn_phase(const Params& P, LAS unsigned char* lds, int layer, int G, int bid, int vcu) {
    int tid = threadIdx.x; asm volatile("" : "+v"(tid));
    const int w = tid >> 6;
    const unsigned char* ws = P.ws + opaque0();
    const float* LF = (const float*)(ws + WS_LF);
    LAS float* c2 = (LAS float*)(lds + AT_C2); LAS float* wtot = (LAS float*)(lds + AT_WTOT);
    LAS float* sc = (LAS float*)(lds + NA_SC) + w * 2064; LAS float* qf = (LAS float*)(lds + NA_QF) + w * 128;
    const bool fox = layer < 2;
    if (fox) {
        for (int it = bid; it < 32; it += G) {
            const int h = it >> 1, r = (it & 1) * 8 + w;
            compute_c2(LF, 0, h, c2, wtot);
            naive_attn_row<0>(ws, 0, h, (const bf16_t*)(ws + WS_QM) + (size_t)r * D + h * DH, MOFF + r, (bf16_t*)(P.ws + WS_OM) + (size_t)r * D + h * DH, c2, sc, qf);
            __syncthreads();
        }
    }
    const bool naive = fox ? (NAIVE_FOX != 0) : (NAIVE_SB != 0);
    if (naive) {
        for (int it = bid; it < NB * NH * 256; it += G) {
            const int bh = it >> 8, b = bh >> 4, h = bh & 15, t = (it & 255) * 8 + w;
            if (fox) compute_c2(LF, b, h, c2, wtot);
            const bf16_t* qptr = (const bf16_t*)(ws + WS_QB) + (size_t)(b * SEQ + t) * D + h * DH; bf16_t* optr = (bf16_t*)(P.ws + WS_OB) + (size_t)(b * SEQ + t) * D + h * DH;
            if (fox) naive_attn_row<0>(ws, b, h, qptr, ROFF + t, optr, c2, sc, qf); else naive_attn_row<1>(ws, b, h, qptr, ROFF + t, optr, c2, sc, qf);
            __syncthreads();
        }
    } else {
        for (int it = vcu; it < NB * NH * 4; it += G) {
            const int bh = it >> 2, b = bh >> 4, h = bh & 15, p = it & 3;
            if (fox) { __syncthreads(); compute_c2(LF, b, h, c2, wtot);
#pragma nounroll
                for (int hf = 0; hf < 2; ++hf) attn_item<0>(ws, lds, b, h, hf ? p : 7 - p); }
            else {
#pragma nounroll
                for (int hf = 0; hf < 2; ++hf) attn_item<1>(ws, lds, b, h, hf ? p : 7 - p); }
        }
    }
    __syncthreads();
}

DI EpiCtx make_epi(const Params& P, unsigned char* ws, int l, int kind) {
    u64* ssq = (u64*)(ws + WS_SSQ); u64* ssqm = (u64*)(ws + WS_SSQM);
    EpiCtx e{}; e.ws = ws; e.bfg = P.fox_b_f + (l < 2 ? l : 0) * NH; e.rsc = 1.f;
    e.ssq_in = ssq; e.ssqm_in = ssqm; e.ssq_out = ssq; e.ssqm_out = ssqm; e.hin = nullptr; e.hmin = (const float*)(ws + WS_HM);
    if (kind == 0) { e.ssq_in = ssq + (size_t)(2 * l) * MR; e.ssqm_in = ssqm + (2 * l) * 16; }
    else if (kind == 2) { if (l == 0) { e.hmin = P.meta; }     e.ssq_out = ssq + (size_t)(2 * l + 1) * MR; e.ssqm_out = ssqm + (2 * l + 1) * 16; }
    else if (kind == 3) { e.ssq_in = ssq + (size_t)(2 * l + 1) * MR; e.ssqm_in = ssqm + (2 * l + 1) * 16; }
    else { e.ssq_out = ssq + (size_t)(2 * l + 2) * MR; e.ssqm_out = ssqm + (2 * l + 2) * 16; }
    return e;
}
DI const bf16_t* phase_w(unsigned char* ws, int l, int kind) {
    if (kind == 0) return (l < 2) ? (const bf16_t*)(ws + WS_WT_IN) + (size_t)l * 3 * D * D : (l == 2 ? (const bf16_t*)(ws + WS_WT_QKV2) : (const bf16_t*)(ws + WS_WT_Q3));
    if (kind == 2) return (l < 2) ? (const bf16_t*)(ws + WS_WT_O) + (size_t)l * D * D : (const bf16_t*)(ws + WS_WT_SO) + (size_t)(l - 2) * D * D;
    if (kind == 3) return (const bf16_t*)(ws + WS_WT_UP) + (size_t)l * FF * D;
    return (const bf16_t*)(ws + WS_WT_DN) + (size_t)l * D * FF;
}
DI pg8::Sched make_sched(unsigned char* ws, int l, int kind, int G, int bid) {
    pg8::Sched S{}; S.G = G; S.c = bid; S.K = (kind == 4) ? FF : D;
    const bf16_t* W = phase_w(ws, l, kind); const bf16_t* HB = (const bf16_t*)(ws + WS_HB);
    S.A0 = HB; S.B0 = W; S.nM0 = 32; S.nN0 = 8; S.ek0 = E_RES; S.A1 = W; S.B1 = HB; S.nM1 = 0; S.nN1 = 0; S.ek1 = E_VT;
    if (kind == 0) { S.nN0 = (l < 3) ? 16 : 8; S.ek0 = E_QK; if (l < 3) { S.A1 = W + (size_t)2 * D * D; S.nM1 = 8; S.nN1 = 32; } }
    else if (kind == 2) { S.A0 = (const bf16_t*)(ws + WS_OB); }
    else if (kind == 3) { S.nN0 = 32; S.ek0 = E_UP; }
    else { S.A0 = (const bf16_t*)(ws + WS_UB); S.ablk = !NAIVE_GEMM; }
    return S;
}
DI SkJob make_job(unsigned char* ws, int l, int kind, int q) {
    SkJob j{}; j.kind = JK_NONE;
    const bf16_t* W = phase_w(ws, l, kind); const bf16_t* HB = (const bf16_t*)(ws + WS_HB); const bf16_t* HBM = (const bf16_t*)(ws + WS_HBM);
    if (q == 0) {
        if (kind == 0) { if (l < 2) j = {HBM, W, D, 384, JK_META_IN, 0, 0, 0, 0}; else if (l == 2) j = {HBM, W + (size_t)D * D, D, 256, JK_META_IN, D, 0, 0, 0}; }
        else if (l < 2) {
            if (kind == 2) j = {(const bf16_t*)(ws + WS_OM), W, D, 128, JK_META_RES, 0, 0, 0, 0};
            else if (kind == 3) j = {HBM, W, D, 512, JK_META_UP, 0, 0, 0, 0};
            else j = {(const bf16_t*)(ws + WS_UM), W, FF, 128, JK_META_RES, 0, 0, 0, 0};
        }
    } else if (q <= 2) {
        if (kind == 0 && l < 2) {
            const bf16_t* WF = (const bf16_t*)(ws + WS_WF) + (size_t)l * 16 * D;
            if (q == 1) j = {WF, HB, D, MR / 16, JK_FG, 0, 0, 0, 0}; else j = {WF, HBM, D, 1, JK_FG_META, 0, 0, 0, 0};
        }
    } else {
        const pg8::Sched S = make_sched(ws, l, kind, 1, 0);
        if (q == 3) j = {S.A0, S.B0, S.K, S.nM0 * 16 * S.nN0 * 16, JK_NAIVE, 0, S.ek0, S.nN0 * 16, 0};
        else j = {S.A1, S.B1, S.K, S.nM1 * 16 * S.nN1 * 16, JK_NAIVE, 0, S.ek1, S.nN1 * 16, 0};
    }
    return j;
}

__global__ void __launch_bounds__(NTHR, 2) yoco_mega(Params P) {
    extern __shared__ __attribute__((aligned(16))) unsigned char smem[];
    LAS unsigned char* lds = (LAS unsigned char*)smem;
    cg::grid_group grid = cg::this_grid();
    const int G = gridDim.x, bid = blockIdx.x;
    unsigned char* ws = P.ws;
    const unsigned xcc = (unsigned)__builtin_amdgcn_s_getreg((3 << 11) | 20) & 7u;
    {
        LAS unsigned* lw = (LAS unsigned*)(lds + LDS_BYTES - 16);
        if (threadIdx.x == 0) lw[0] = __hip_atomic_fetch_add((unsigned*)(ws + WS_BAR) + 8 + xcc, 1u, __ATOMIC_RELAXED, __HIP_MEMORY_SCOPE_AGENT);
        __syncthreads();
    }
    const unsigned xrank = __builtin_amdgcn_readfirstlane(((LAS unsigned*)(lds + LDS_BYTES - 16))[0]);
    phase0(P, lds, G, bid);
#if DUP_P0
    __syncthreads(); phase0(P, lds, G, bid);
#endif
    asm volatile("s_waitcnt vmcnt(0) lgkmcnt(0)" ::: "memory");
    grid.sync();
    unsigned* barcnt = (unsigned*)(ws + WS_BAR); unsigned nbar = 0;
    int vcu;
    bool xok; unsigned kx = 0;
    {
        bool ok = (G == 256);
        for (int i = 0; i < 8; ++i) ok = ok && (__hip_atomic_load((unsigned*)(ws + WS_BAR) + 8 + i, __ATOMIC_RELAXED, __HIP_MEMORY_SCOPE_AGENT) == 32u);
        vcu = ok ? (int)(xcc * 32u + xrank) : ((G % 8 == 0) ? (bid % 8) * (G / 8) + bid / 8 : bid);
        xok = ok;
    }
#define GBAR() do { if (xok) grid_bar_x(barcnt, xcc, ++kx); else grid_bar(barcnt, ++nbar * (unsigned)G); } while (0)
    const int vc = (G % 8 == 0) ? (vcu % (G / 8)) * 8 + vcu / (G / 8) : vcu;
#pragma nounroll
    for (int step0 = 0; step0 < 20 + DUP_STEP; ++step0) {
        const int step = (DUP_STEP && step0 > DUP_STEP_AT) ? step0 - 1 : step0;
        const int l = step / 5, kind = step % 5;
        if (kind == 1) { attn_phase(P, lds, l, G, bid, vcu);
#if DUP_FOX
            if (l == 0) attn_phase(P, lds, l, G, bid, vcu);
#endif
#if DUP_SB
            if (l == 2) attn_phase(P, lds, l, G, bid, vcu);
#endif
        }
        else {
#if !NAIVE_GEMM
            {
                unsigned char* wsl = P.ws + opaque0();
                const EpiCtx e = make_epi(P, wsl, l, kind);
                const pg8::Sched S = make_sched(wsl, l, kind, G, vc);
                pg8::gemm_phase(lds, S, e);
#if DUP_UP
                if (kind == 3 && l == 0) pg8::gemm_phase(lds, S, e);
#endif
#if DUP_RES
                if (kind == DUP_RES && l == 0) { GBAR(); EpiCtx e2 = e; e2.rsc = 0.f; e2.hin = nullptr; pg8::Sched S2 = S; S2.pmmask = DUP_PMMASK; pg8::gemm_phase(lds, S2, e2); }
#endif
            }
#endif
#pragma nounroll
            for (int q = 0; q < (NAIVE_GEMM ? 5 : 3); ++q) {
                unsigned char* wsl = P.ws + opaque0();
                const EpiCtx e = make_epi(P, wsl, l, kind);
                const SkJob jb = make_job(wsl, l, kind, q);
                skinny_items(jb, e, lds, G, bid);
            }
        }
        GBAR();
    }
#if DUP_BAR
    for (int i = 0; i < DUP_BAR; ++i) GBAR();
#endif
    {
        int tid = threadIdx.x; asm volatile("" : "+v"(tid));
        const int lane = tid & 63, w = tid >> 6;
        const u64* ssq = (const u64*)(ws + WS_SSQ) + (size_t)8 * MR; const bf16_t* hb = (const bf16_t*)(ws + WS_HB);
        for (int r = bid * 8 + w; r < MR; r += G * 8) {
            const float rs = rstd_of(ssq[r]);
            const u32x4* src = (const u32x4*)(hb + (size_t)r * D) + lane; const f32x4* gg = (const f32x4*)P.final_norm; f32x4* dst = (f32x4*)(P.out + (size_t)r * D);
#pragma unroll
            for (int j = 0; j < 4; ++j) {
                const u32x4 t = src[64 * j]; const int c4 = (lane + 64 * j) * 2;
                const f32x4 a0 = {bflo(t.x), bfhi(t.x), bflo(t.y), bfhi(t.y)}, a1 = {bflo(t.z), bfhi(t.z), bflo(t.w), bfhi(t.w)};
                dst[c4] = a0 * rs * gg[c4]; dst[c4 + 1] = a1 * rs * gg[c4 + 1];
            }
        }
    }
}

extern "C" void kernel_launch(void* const* d_in, const int* in_sizes, int n_in, void* d_out, int out_size, void* d_ws, size_t ws_size, hipStream_t stream) {
    static int grid = 0;
    if (grid == 0) {
        if (n_in != 14 || out_size != MR * D || ws_size < WS_END) { fprintf(stderr, "kernel_launch: unexpected shapes (n_in %d out %d ws %zu need %zu)\n", n_in, out_size, ws_size, (size_t)WS_END); grid = -1; return; }
        int dev = 0, cus = 0, per_cu = 0;
        hipGetDevice(&dev);
        hipDeviceGetAttribute(&cus, hipDeviceAttributeMultiprocessorCount, dev);
        if (hipFuncSetAttribute((const void*)yoco_mega, hipFuncAttributeMaxDynamicSharedMemorySize, LDS_BYTES) != hipSuccess) { fprintf(stderr, "kernel_launch: hipFuncSetAttribute failed\n"); grid = -1; return; }
        hipOccupancyMaxActiveBlocksPerMultiprocessor(&per_cu, (const void*)yoco_mega, NTHR, LDS_BYTES);
        (void)hipGetLastError();
        if (per_cu < 1) per_cu = 1;
        grid = cus * 1;
        fprintf(stderr, "kernel_launch: cus %d per_cu %d grid %d\n", cus, per_cu, grid);
    }
    if (grid < 0) return;
    Params p{};
    p.x = (const float*)d_in[0]; p.meta = (const float*)d_in[1]; p.norm_attn = (const float*)d_in[2]; p.norm_mlp = (const float*)d_in[3];
    p.w_up = (const float*)d_in[4]; p.w_down = (const float*)d_in[5]; p.fox_w_in = (const float*)d_in[6]; p.fox_b_f = (const float*)d_in[7];
    p.fox_w_o = (const float*)d_in[8]; p.kv_norm = (const float*)d_in[9]; p.w_kv = (const float*)d_in[10]; p.sb_w_q = (const float*)d_in[11];
    p.sb_w_o = (const float*)d_in[12]; p.final_norm = (const float*)d_in[13];
    p.out = (float*)d_out; p.ws = (unsigned char*)d_ws;
    if (hipMemsetAsync((unsigned char*)d_ws + WS_BAR, 0, 256, stream) != hipSuccess) { fprintf(stderr, "kernel_launch: memset failed\n"); return; }
    void* args[] = {&p};
    hipError_t e = hipLaunchCooperativeKernel((const void*)yoco_mega, dim3(grid), dim3(NTHR), args, LDS_BYTES, stream);
    if (e != hipSuccess) fprintf(stderr, "cooperative launch failed: %s (grid %d)\n", hipGetErrorString(e), grid);
}
```

```cpp
#include <hip/hip_runtime.h>
#include <hip/hip_cooperative_groups.h>
#include <cstdio>
#include <cstdint>
namespace cg = cooperative_groups;

#ifndef NAIVE_GEMM
#define NAIVE_GEMM 0
#endif
#ifndef NAIVE_FOX
#define NAIVE_FOX 0
#endif
#ifndef NAIVE_SB
#define NAIVE_SB 0
#endif

#ifndef GEMM_SP2
#define GEMM_SP2 1
#endif
#ifndef DUP_STEP
#define DUP_STEP 0
#endif
#ifndef DUP_STEP_AT
#define DUP_STEP_AT 3
#endif
#ifndef DUP_RES
#define DUP_RES 0
#endif
#ifndef DUP_PMMASK
#define DUP_PMMASK 0
#endif
#ifndef DUP_BAR
#define DUP_BAR 0
#endif
#ifndef DUP_P0
#define DUP_P0 0
#endif
#ifndef DUP_FOX
#define DUP_FOX 0
#endif
#ifndef DUP_SB
#define DUP_SB 0
#endif
#ifndef DUP_UP
#define DUP_UP 0
#endif
#define LAS __attribute__((address_space(3)))
#define DI __device__ __forceinline__
typedef unsigned short bf16_t;
typedef short bf16x8 __attribute__((ext_vector_type(8)));
typedef float f32x4 __attribute__((ext_vector_type(4)));
typedef float f32x16 __attribute__((ext_vector_type(16)));
typedef unsigned u32x4 __attribute__((ext_vector_type(4)));
typedef unsigned u32x2 __attribute__((ext_vector_type(2)));

constexpr int D = 2048, NB = 4, SEQ = 2048, NH = 16, DH = 128, FF = 8192, NMETA = 16;
constexpr int MR = NB * SEQ;
constexpr int LP = 2112;
constexpr int MOFF = 48, ROFF = 64;
constexpr int NIN = 3 * D + NH;
constexpr int VLD = NB * LP;
constexpr float EPS = 1e-6f;
constexpr float LOG2E = 1.4426950408889634f;
constexpr float QSCALE = 0.08838834764831845f * LOG2E;
constexpr int NTHR = 512;
constexpr int LDS_BYTES = 147456;

constexpr size_t SZ_DD = (size_t)D * D * 2;
constexpr size_t WS_WT_IN = 0;
constexpr size_t WS_WF = WS_WT_IN + 2 * 3 * SZ_DD;
constexpr size_t WS_WT_O = WS_WF + 2 * 16 * D * 2;
constexpr size_t WS_WT_UP = WS_WT_O + 2 * SZ_DD;
constexpr size_t WS_WT_DN = WS_WT_UP + 4 * 4 * SZ_DD;
constexpr size_t WS_WT_QKV2 = WS_WT_DN + 4 * 4 * SZ_DD;
constexpr size_t WS_WT_Q3 = WS_WT_QKV2 + 3 * SZ_DD;
constexpr size_t WS_WT_SO = WS_WT_Q3 + SZ_DD;
constexpr size_t WS_H = WS_WT_SO + 2 * SZ_DD;
constexpr size_t WS_HB = WS_H + (size_t)MR * D * 4;
constexpr size_t WS_QB = WS_HB + (size_t)MR * D * 2;
constexpr size_t WS_KB = WS_QB + (size_t)MR * D * 2;
constexpr size_t WS_VT = WS_KB + (size_t)NB * LP * D * 2;
constexpr size_t WS_OB = WS_VT + (size_t)D * VLD * 2;
constexpr size_t WS_UB = WS_OB + (size_t)MR * D * 2;
constexpr size_t WS_SSQ = WS_UB + (size_t)MR * FF * 2;
constexpr size_t WS_LF = WS_SSQ + 9 * (size_t)MR * 8;
constexpr size_t WS_HM = WS_LF + (size_t)NB * NH * LP * 4;
constexpr size_t WS_HBM = WS_HM + 16 * D * 4;
constexpr size_t WS_QM = WS_HBM + 16 * D * 2;
constexpr size_t WS_OM = WS_QM + 16 * D * 2;
constexpr size_t WS_UM = WS_OM + 16 * D * 2;
constexpr size_t WS_SSQM = WS_UM + 16 * FF * 2;
constexpr size_t WS_BAR = (WS_SSQM + 9 * 16 * 8 + 255) / 256 * 256;
constexpr size_t WS_END = WS_BAR + 256;

struct Params {
    const float *x, *meta, *norm_attn, *norm_mlp, *w_up, *w_down, *fox_w_in, *fox_b_f, *fox_w_o, *kv_norm, *w_kv, *sb_w_q, *sb_w_o, *final_norm;
    float* out; unsigned char* ws;
};

DI unsigned f2bf(float f) { unsigned u = __float_as_uint(f); u += 0x7FFFu + ((u >> 16) & 1u); return u >> 16; }
typedef float f32x2_t __attribute__((ext_vector_type(2)));
typedef __bf16 bf16x2_t __attribute__((ext_vector_type(2)));
DI unsigned pk2(float lo, float hi) { f32x2_t v = {lo, hi}; return __builtin_bit_cast(unsigned, __builtin_convertvector(v, bf16x2_t)); }
DI float bf2f(unsigned short b) { return __uint_as_float(((unsigned)b) << 16); }
DI float bflo(unsigned w) { return __uint_as_float(w << 16); }
DI float bfhi(unsigned w) { return __uint_as_float(w & 0xFFFF0000u); }
DI float ex2(float x) { return __builtin_amdgcn_exp2f(x); }
DI float lg2(float x) { return __builtin_amdgcn_logf(x); }
typedef unsigned long long u64;
constexpr float SSQ_SCALE = 16777216.0f;
DI float rstd_of(u64 ssq) { const float f = (float)(unsigned)(ssq >> 32) * 4294967296.0f + (float)(unsigned)ssq;
    return __builtin_amdgcn_rsqf(f * (1.0f / (SSQ_SCALE * D)) + EPS); }
DI u64 ssq_fix(float s) { return (u64)(s * SSQ_SCALE + 0.5f); }
DI int prow_of(int tok) { return (tok >> 11) * LP + ROFF + (tok & 2047); }
DI float wave_sum(float v) {
#pragma unroll
    for (int o = 1; o < 64; o <<= 1) v += __shfl_xor(v, o);
    return v;
}
DI float wave_max(float v) {
#pragma unroll
    for (int o = 1; o < 64; o <<= 1) v = fmaxf(v, __shfl_xor(v, o));
    return v;
}
DI size_t opaque0() { size_t z = 0; asm volatile("" : "+s"(z)); return z; }
DI float xor32(float x, int lane) {
    const unsigned u = __float_as_uint(x); const auto r = __builtin_amdgcn_permlane32_swap(u, u, false, false);
    return __uint_as_float((lane & 32) ? r[0] : r[1]); }
DI void lds_fence() { asm volatile("s_waitcnt lgkmcnt(0)" ::: "memory"); __builtin_amdgcn_wave_barrier(); }

DI void grid_bar(unsigned* cnt, unsigned target) {
    asm volatile("s_waitcnt vmcnt(0) lgkmcnt(0)" ::: "memory");
    __syncthreads();
    if (threadIdx.x == 0) {
        __builtin_amdgcn_fence(__ATOMIC_RELEASE, "agent");
        __hip_atomic_fetch_add(cnt, 1u, __ATOMIC_RELAXED, __HIP_MEMORY_SCOPE_AGENT);
        while (__hip_atomic_load(cnt, __ATOMIC_RELAXED, __HIP_MEMORY_SCOPE_AGENT) < target) __builtin_amdgcn_s_sleep(2);
        __builtin_amdgcn_fence(__ATOMIC_ACQUIRE, "agent");
    }
    __syncthreads();
}

DI void grid_bar_x(unsigned* base, unsigned xcc, unsigned k) {
    asm volatile("s_waitcnt vmcnt(0) lgkmcnt(0)" ::: "memory");
    __syncthreads();
    if (threadIdx.x == 0) {
        const unsigned old = __hip_atomic_fetch_add(base + 16 + xcc, 1u, __ATOMIC_RELAXED, __HIP_MEMORY_SCOPE_AGENT);
        if (old + 1u == 32u * k) {
            __builtin_amdgcn_fence(__ATOMIC_RELEASE, "agent");
            __hip_atomic_fetch_add(base + 24, 1u, __ATOMIC_RELAXED, __HIP_MEMORY_SCOPE_AGENT);
        }
        while (__hip_atomic_load(base + 24, __ATOMIC_RELAXED, __HIP_MEMORY_SCOPE_AGENT) < 8u * k) { }
        __builtin_amdgcn_fence(__ATOMIC_ACQUIRE, "agent");
    }
    __syncthreads();
}

enum { E_QK = 0, E_VT = 1, E_FG = 2, E_RES = 3, E_UP = 4 };
struct EpiCtx {
    unsigned char* ws;
    const u64* ssq_in;  const u64* ssqm_in;
    u64* ssq_out; u64* ssqm_out;
    const float* hin; const float* hmin;
    const float* bfg;
    float rsc;
};

DI float epi_elem(const EpiCtx& e, int ek, bool meta, int row, int col, float v) {
    unsigned char* ws = e.ws;
    if (ek == E_QK) {
        const float val = v * rstd_of(meta ? e.ssqm_in[row] : e.ssq_in[row]);
        const bf16_t o = (bf16_t)f2bf(val);
        if (col < D) { bf16_t* q = (bf16_t*)(ws + (meta ? WS_QM : WS_QB)); q[(size_t)row * D + col] = o; }
        else {
            bf16_t* kb = (bf16_t*)(ws + WS_KB);
            if (meta) { for (int b = 0; b < NB; ++b) kb[((size_t)b * LP + MOFF + row) * D + (col - D)] = o; }
            else kb[(size_t)prow_of(row) * D + (col - D)] = o;
        }
        return 0.f;
    } else if (ek == E_VT) {
        const float val = v * rstd_of(meta ? e.ssqm_in[col] : e.ssq_in[col]);
        const bf16_t o = (bf16_t)f2bf(val);
        bf16_t* vt = (bf16_t*)(ws + WS_VT);
        if (meta) { for (int b = 0; b < NB; ++b) vt[(size_t)row * VLD + b * LP + MOFF + col] = o; }
        else vt[(size_t)row * VLD + prow_of(col)] = o;
        return 0.f;
    } else if (ek == E_FG) {
        const float xx = v * rstd_of(meta ? e.ssqm_in[col] : e.ssq_in[col]) + e.bfg[row];
        const float lf = fminf(xx, 0.f) - log1pf(expf(-fabsf(xx)));
        float* LF = (float*)(ws + WS_LF);
        if (meta) { for (int b = 0; b < NB; ++b) LF[((size_t)b * NH + row) * LP + MOFF + col] = lf; }
        else LF[((size_t)(col >> 11) * NH + row) * LP + ROFF + (col & 2047)] = lf;
        return 0.f;
    } else if (ek == E_RES) {
        bf16_t* hb = (bf16_t*)(ws + (meta ? WS_HBM : WS_HB));
        float base;
        if (meta) base = e.hmin[(size_t)row * D + col]; else base = e.hin ? e.hin[(size_t)row * D + col] : bf2f(hb[(size_t)row * D + col]);
        const float hn = base + v;
        if (meta) ((float*)(ws + WS_HM))[(size_t)row * D + col] = hn;
        hb[(size_t)row * D + col] = (bf16_t)f2bf(hn);
        return hn * hn;
    } else {
        float t = v * rstd_of(meta ? e.ssqm_in[row] : e.ssq_in[row]); t = fmaxf(t, 0.f); t = t * t;
        bf16_t* u = (bf16_t*)(ws + (meta ? WS_UM : WS_UB)); u[(size_t)row * FF + col] = (bf16_t)f2bf(t);
        return 0.f;
    }
}

enum { JK_NONE = 0, JK_META_IN, JK_FG, JK_FG_META, JK_META_RES, JK_META_UP, JK_NAIVE };
struct SkJob { const bf16_t* X; const bf16_t* Y; int K; int n; int kind; int colofs; int ek; int nNt; int yIsItemN; };

DI void skinny_items(const SkJob& jb, const EpiCtx& e_in, LAS unsigned char* lds, int G, int bid) {
    if (jb.kind == JK_NONE || jb.n <= 0) return;
    int tid = threadIdx.x; asm volatile("" : "+v"(tid));
    const int lane = tid & 63, w = __builtin_amdgcn_readfirstlane(tid >> 6);
    const int K = jb.K, kw = K >> 3;
    LAS f32x4* red = (LAS f32x4*)lds;
    for (int it = bid; it < jb.n; it += G) {
        EpiCtx e = e_in; e.ws = e_in.ws + opaque0();
        int xi = 0, yi = it;
        if (jb.kind == JK_NAIVE) { xi = it / jb.nNt; yi = it % jb.nNt; }
        else if (jb.kind == JK_FG_META) { yi = 0; }
        const bf16_t* xp = jb.X + ((size_t)xi * 16 + (lane & 15)) * K + w * kw + 8 * (lane >> 4);
        const bf16_t* yp = jb.Y + ((size_t)yi * 16 + (lane & 15)) * K + w * kw + 8 * (lane >> 4);
        f32x4 acc = {0.f, 0.f, 0.f, 0.f};
        for (int s = 0; s < kw; s += 256) {
            bf16x8 a[8], b[8];
#pragma unroll
            for (int i = 0; i < 8; ++i) { a[i] = *(const bf16x8*)(xp + s + 32 * i); b[i] = *(const bf16x8*)(yp + s + 32 * i); }
#pragma unroll
            for (int i = 0; i < 8; ++i) acc = __builtin_amdgcn_mfma_f32_16x16x32_bf16(a[i], b[i], acc, 0, 0, 0);
        }
        __syncthreads();
        red[w * 64 + lane] = acc;
        __syncthreads();
        if (w == 0) {
            f32x4 s = red[lane];
#pragma unroll
            for (int i = 1; i < 8; ++i) s += red[i * 64 + lane];
            const int j = lane & 15, i0 = 4 * (lane >> 4);
#pragma unroll
            for (int r = 0; r < 4; ++r) {
                const int i = i0 + r; const float v = s[r];
                float sq = 0.f; bool resm = false; int rrow = 0;
                switch (jb.kind) {
                    case JK_META_IN: { const int n = jb.colofs + it * 16 + j; if (n < 2 * D) epi_elem(e, E_QK, true, i, n, v); else epi_elem(e, E_VT, true, n - 2 * D, i, v); } break;
                    case JK_FG: epi_elem(e, E_FG, false, i, it * 16 + j, v); break;
                    case JK_FG_META: epi_elem(e, E_FG, true, i, j, v); break;
                    case JK_META_RES: sq = epi_elem(e, E_RES, true, i, it * 16 + j, v); resm = true; rrow = i; break;
                    case JK_META_UP: epi_elem(e, E_UP, true, i, it * 16 + j, v); break;
                    default: {
                        const int row = xi * 16 + i, col = yi * 16 + j;
                        sq = epi_elem(e, jb.ek, false, row, col, v); rrow = row; } break;
                }
                if (jb.kind == JK_META_RES || (jb.kind == JK_NAIVE && jb.ek == E_RES)) {
                    sq += __shfl_xor(sq, 1); sq += __shfl_xor(sq, 2); sq += __shfl_xor(sq, 4); sq += __shfl_xor(sq, 8);
                    if (j == 0) __hip_atomic_fetch_add((resm ? e.ssqm_out : e.ssq_out) + rrow, ssq_fix(sq), __ATOMIC_RELAXED, __HIP_MEMORY_SCOPE_AGENT);
                }
            }
        }
    }
    __syncthreads();
}

namespace pg8 {
constexpr int BM = 256, BK = 64, HALF = 128, HTB = HALF * BK * 2, STAGE_BYTES = 8 * HTB, NXCD = 8, WGM = 4;
DI int lds_byte(int r, int c) { const int st = (r >> 4) * 2 + (c >> 5), rr = r & 15, cc = c & 31, ob = rr * 64 + cc * 2; return st * 1024 + (ob ^ (((ob >> 9) & 1) << 5)); }
DI void stage_rc(int b, int& R, int& C) { const int st = b / 1024, sb = b % 1024, swz = sb ^ (((sb >> 9) & 1) << 5); R = (st >> 1) * 16 + swz / 64; C = (st & 1) * 32 + (swz % 64) / 2; }
DI int perm32(int rho) { const int n = rho >> 4, i = rho & 15; return 8 * (i >> 2) + 4 * n + (i & 3); }

struct Unit { const char* a; const char* b; int pm, pn, ek; };
struct Sched {
    const bf16_t *A0, *B0, *A1, *B1; int nM0, nN0, ek0, nM1, nN1, ek1, K, G, c; int ablk;
    int pmmask;
    DI bool next(int i, Unit& u) const {
        int L = i * G + c; const int n0 = nM0 * nN0, n1 = nM1 * nN1;
        const bool second = L >= n0;
        if (second) { L -= n0; if (L >= n1) return false; }
        const bf16_t* A = second ? A1 : A0; const bf16_t* B = second ? B1 : B0;
        const int nM = second ? nM1 : nM0, nN = second ? nN1 : nN0, nwg = nM * nN;
        int wgid = L; { const int q = nwg / NXCD, r = nwg % NXCD, xcd = wgid % NXCD, off = wgid / NXCD; wgid = (xcd < r ? xcd * (q + 1) : r * (q + 1) + (xcd - r) * q) + off; }
        const int nig = WGM * nN, gid = wgid / nig, fm = gid * WGM, gsz = (nM - fm) < WGM ? (nM - fm) : WGM;
        u.pm = fm + ((wgid % nig) % gsz); u.pn = (wgid % nig) / gsz; u.ek = second ? ek1 : ek0;
        const size_t tstep = (size_t)BM * K * 2;
        u.a = (const char*)A + (size_t)(pmmask ? (u.pm & pmmask) : u.pm) * tstep; u.b = (const char*)B + (size_t)u.pn * tstep;
        return true;
    }
};

DI void epilogue(const f32x4 (&acc)[2][2][4][2], const Unit& u, const EpiCtx& e, int wr, int wc, int fr, int fq) {
    unsigned char* ws = e.ws + opaque0();
    const int row0 = u.pm * BM + wr * 64 + fr, col0 = u.pn * BM + wc * 32 + 8 * fq;
    if (u.ek == E_VT) {
        bf16_t* vt = (bf16_t*)(ws + WS_VT);
#pragma unroll
        for (int bj = 0; bj < 2; ++bj) {
            const int tok = col0 + bj * HALF;
            f32x4 r0, r1;
#pragma unroll
            for (int j = 0; j < 4; ++j) { r0[j] = rstd_of(e.ssq_in[tok + j]); r1[j] = rstd_of(e.ssq_in[tok + 4 + j]); }
            const int pc = prow_of(tok);
#pragma unroll
            for (int ai = 0; ai < 2; ++ai)
#pragma unroll
                for (int m = 0; m < 4; ++m) {
                    const int row = row0 + ai * HALF + m * 16;
                    const f32x4 v0 = acc[ai][bj][m][0] * r0, v1 = acc[ai][bj][m][1] * r1;
                    u32x4 w; w.x = pk2(v0[0], v0[1]); w.y = pk2(v0[2], v0[3]); w.z = pk2(v1[0], v1[1]); w.w = pk2(v1[2], v1[3]);
                    *(u32x4*)(vt + (size_t)row * VLD + pc) = w;
                }
        }
        return;
    }
    if (u.ek == E_RES) {
        bf16_t* hb = (bf16_t*)(ws + WS_HB);
#define RES_ROW(V0, V1) do { \
                    const f32x4 v0 = (V0) + acc[ai][bj][m][0] * e.rsc, v1 = (V1) + acc[ai][bj][m][1] * e.rsc; \
                    u32x4 w; w.x = pk2(v0[0], v0[1]); w.y = pk2(v0[2], v0[3]); w.z = pk2(v1[0], v1[1]); w.w = pk2(v1[2], v1[3]); \
                    *(u32x4*)(hb + off) = w; \
                    ss += (v0[0] * v0[0] + v0[1] * v0[1]) + (v0[2] * v0[2] + v0[3] * v0[3]) + (v1[0] * v1[0] + v1[1] * v1[1]) + (v1[2] * v1[2] + v1[3] * v1[3]); } while (0)
#define RES_STAT() do { ss += __shfl_xor(ss, 16); ss += __shfl_xor(ss, 32); \
                    if (fq == 0 && e.rsc != 0.f) __hip_atomic_fetch_add(e.ssq_out + row, ssq_fix(ss), __ATOMIC_RELAXED, __HIP_MEMORY_SCOPE_AGENT); } while (0)
        if (e.hin) {
#pragma unroll
            for (int ai = 0; ai < 2; ++ai) {
                f32x4 r[4][2][2];
#pragma unroll
                for (int m = 0; m < 4; ++m)
#pragma unroll
                    for (int bj = 0; bj < 2; ++bj) { const size_t off = (size_t)(row0 + ai * HALF + m * 16) * D + col0 + bj * HALF; r[m][bj][0] = *(const f32x4*)(e.hin + off); r[m][bj][1] = *(const f32x4*)(e.hin + off + 4); }
#pragma unroll
                for (int m = 0; m < 4; ++m) {
                    const int row = row0 + ai * HALF + m * 16; float ss = 0.f;
#pragma unroll
                    for (int bj = 0; bj < 2; ++bj) { const size_t off = (size_t)row * D + col0 + bj * HALF; RES_ROW(r[m][bj][0], r[m][bj][1]); }
                    RES_STAT();
                }
                asm volatile("" ::: "memory");
            }
        } else {
            u32x4 q[2][4][2];
#pragma unroll
            for (int ai = 0; ai < 2; ++ai)
#pragma unroll
                for (int m = 0; m < 4; ++m)
#pragma unroll
                    for (int bj = 0; bj < 2; ++bj) q[ai][m][bj] = *(const u32x4*)(hb + (size_t)(row0 + ai * HALF + m * 16) * D + col0 + bj * HALF);
#pragma unroll
            for (int ai = 0; ai < 2; ++ai)
#pragma unroll
                for (int m = 0; m < 4; ++m) {
                    const int row = row0 + ai * HALF + m * 16; float ss = 0.f;
#pragma unroll
                    for (int bj = 0; bj < 2; ++bj) {
                        const size_t off = (size_t)row * D + col0 + bj * HALF; const u32x4 t = q[ai][m][bj];
                        const f32x4 a0 = {bflo(t.x), bfhi(t.x), bflo(t.y), bfhi(t.y)}, a1 = {bflo(t.z), bfhi(t.z), bflo(t.w), bfhi(t.w)};
                        RES_ROW(a0, a1);
                    }
                    RES_STAT();
                }
        }
#undef RES_ROW
#undef RES_STAT
        return;
    }
#pragma unroll
    for (int ai = 0; ai < 2; ++ai)
#pragma unroll
        for (int m = 0; m < 4; ++m) {
            const int row = row0 + ai * HALF + m * 16;
            if (u.ek == E_QK) {
                const float rs = rstd_of(e.ssq_in[row]);
#pragma unroll
                for (int bj = 0; bj < 2; ++bj) {
                    const int col = col0 + bj * HALF;
                    const f32x4 v0 = acc[ai][bj][m][0] * rs, v1 = acc[ai][bj][m][1] * rs;
                    u32x4 w; w.x = pk2(v0[0], v0[1]); w.y = pk2(v0[2], v0[3]); w.z = pk2(v1[0], v1[1]); w.w = pk2(v1[2], v1[3]);
                    bf16_t* dst = (col < D) ? (bf16_t*)(ws + WS_QB) + (size_t)row * D + col : (bf16_t*)(ws + WS_KB) + (size_t)prow_of(row) * D + (col - D);
                    *(u32x4*)dst = w;
                }
            } else if (u.ek == E_UP) {
                const float rs = rstd_of(e.ssq_in[row]);
#pragma unroll
                for (int bj = 0; bj < 2; ++bj) {
                    const int col = col0 + bj * HALF;
                    f32x4 v0 = acc[ai][bj][m][0] * rs, v1 = acc[ai][bj][m][1] * rs;
#pragma unroll
                    for (int j = 0; j < 4; ++j) { v0[j] = fmaxf(v0[j], 0.f); v0[j] *= v0[j]; v1[j] = fmaxf(v1[j], 0.f); v1[j] *= v1[j]; }
                    u32x4 w; w.x = pk2(v0[0], v0[1]); w.y = pk2(v0[2], v0[3]); w.z = pk2(v1[0], v1[1]); w.w = pk2(v1[2], v1[3]);
                    *(u32x4*)((bf16_t*)(ws + WS_UB) + ((size_t)(row >> 8) * (FF / 64) + (col >> 6)) * 16384 + (row & 255) * 64 + (col & 63)) = w;
                }
            }
        }
}

DI void gemm_phase(LAS unsigned char* lds, const Sched& S, const EpiCtx& E) {
    int tid = threadIdx.x; asm volatile("" : "+v"(tid));
    const int wid = __builtin_amdgcn_readfirstlane(tid >> 6), lane = tid & 63, wr = wid >> 2, wc = wid & 3, fr = lane & 15, fq = lane >> 4;
    const int K = S.K, nt = K / BK;
    unsigned voffA[2], voffB[2];
#pragma unroll
    for (int i = 0; i < 2; ++i) { int R, C; stage_rc(tid * 16 + i * 8192, R, C); const int Rb = (R & ~31) + perm32(R & 31);
        voffA[i] = (unsigned)(R * (S.ablk ? BK : K) + C) * 2u; voffB[i] = (unsigned)(Rb * K + C) * 2u; }
    const size_t kstep = (size_t)(BK * 2);
    const size_t hstep = (size_t)HALF * K * 2;
    const size_t kstepA = S.ablk ? (size_t)BM * BK * 2 : kstep;
    const size_t hstepA = S.ablk ? (size_t)HALF * BK * 2 : hstep;
    const unsigned ldsw = (unsigned)wid * 1024u;
    const int aoff = lds_byte(wr * 64 + fr, fq * 8), boff = lds_byte(wc * 32 + fr, fq * 8);
#define PG8_SA(b, h) (((b) * 2 + (h)) * HTB)
#define PG8_SB(b, h) ((4 + (b) * 2 + (h)) * HTB)
#define PG8_STAGE(bufoff, gbase, voff) do { _Pragma("unroll") for (int _i = 0; _i < 2; ++_i) \
        __builtin_amdgcn_global_load_lds((const unsigned*)((const char*)(gbase) + (voff)[_i]), (LAS unsigned*)(lds + (bufoff) + ldsw + _i * 8192), 16, 0, 0); } while (0)
#define PG8_LDA(dst, b, h) do { _Pragma("unroll") for (int m = 0; m < 4; ++m) _Pragma("unroll") for (int k = 0; k < 2; ++k) dst[m][k] = *(const LAS bf16x8*)(lds + PG8_SA(b, h) + aoff + m * 2048 + k * 1024); } while (0)
#define PG8_LDB(dst, b, h) do { _Pragma("unroll") for (int n = 0; n < 2; ++n) _Pragma("unroll") for (int k = 0; k < 2; ++k) dst[n][k] = *(const LAS bf16x8*)(lds + PG8_SB(b, h) + boff + n * 2048 + k * 1024); } while (0)
#define PG8_MMA(ai, bj, At, Bt) do { __builtin_amdgcn_s_setprio(1); _Pragma("unroll") for (int m = 0; m < 4; ++m) _Pragma("unroll") for (int n = 0; n < 2; ++n) _Pragma("unroll") for (int k = 0; k < 2; ++k) \
        acc[ai][bj][m][n] = __builtin_amdgcn_mfma_f32_16x16x32_bf16(Bt[n][k], At[m][k], acc[ai][bj][m][n], 0, 0, 0); __builtin_amdgcn_s_setprio(0); } while (0)
#define PG8_WAIT_V(n) asm volatile("s_waitcnt vmcnt(" #n ")" ::: "memory")
#define PG8_WAIT_L(n) asm volatile("s_waitcnt lgkmcnt(" #n ")" ::: "memory")
#define PG8_BAR __builtin_amdgcn_s_barrier()
#define PG8_SCHED __builtin_amdgcn_sched_barrier(0)
    Unit cur, nxt; int ui = 0;
    if (!S.next(0, cur)) return;
    f32x4 acc[2][2][4][2];
#pragma unroll
    for (int a = 0; a < 2; ++a)
#pragma unroll
        for (int b = 0; b < 2; ++b)
#pragma unroll
            for (int m = 0; m < 4; ++m)
#pragma unroll
                for (int n = 0; n < 2; ++n) acc[a][b][m][n] = (f32x4){0.f, 0.f, 0.f, 0.f};
    bf16x8 At[4][2], B0[2][2], B1[2][2];
    const char* cA = cur.a; const char* cB = cur.b;
#if GEMM_SP2
    PG8_STAGE(PG8_SB(0, 0), cB, voffB); PG8_STAGE(PG8_SB(0, 1), cB + hstep, voffB); PG8_STAGE(PG8_SA(0, 0), cA, voffA); PG8_STAGE(PG8_SA(0, 1), cA + hstepA, voffA);
    if (wr == 1) PG8_BAR;
    PG8_WAIT_V(2); PG8_BAR;
    PG8_STAGE(PG8_SB(1, 0), cB + kstep, voffB); PG8_STAGE(PG8_SA(1, 0), cA + kstepA, voffA); PG8_STAGE(PG8_SB(1, 1), cB + hstep + kstep, voffB);
    PG8_WAIT_V(6); PG8_BAR;
#else
    PG8_STAGE(PG8_SB(0, 0), cB, voffB); PG8_STAGE(PG8_SA(0, 0), cA, voffA); PG8_STAGE(PG8_SB(0, 1), cB + hstep, voffB); PG8_STAGE(PG8_SA(0, 1), cA + hstepA, voffA);
    if (wr == 1) PG8_BAR;
    PG8_WAIT_V(4); PG8_BAR;
    PG8_STAGE(PG8_SB(1, 0), cB + kstep, voffB); PG8_STAGE(PG8_SA(1, 0), cA + kstepA, voffA); PG8_STAGE(PG8_SB(1, 1), cB + hstep + kstep, voffB);
    PG8_WAIT_V(6); PG8_BAR;
#endif
    for (;;) {
        const bool has_next = S.next(ui + 1, nxt);
        const char* nA = has_next ? nxt.a : cA; const char* nB = has_next ? nxt.b : cB;
        for (int t = 0; t < nt; t += 2) {
            const bool last = (t == nt - 2);
            const char* a1 = cA + (size_t)(t + 1) * kstepA;
            const char* a2 = last ? nA : cA + (size_t)(t + 2) * kstepA; const char* b2 = last ? nB : cB + (size_t)(t + 2) * kstep;
            const char* a3 = a2 + kstepA; const char* b3 = b2 + kstep;
#if GEMM_SP2
            PG8_LDB(B0, 0, 0); PG8_LDB(B1, 0, 1); PG8_SCHED; PG8_LDA(At, 0, 0); PG8_STAGE(PG8_SA(1, 1), a1 + hstepA, voffA);
            PG8_WAIT_V(8); PG8_WAIT_L(0); PG8_BAR; PG8_MMA(0, 0, At, B0); PG8_MMA(0, 1, At, B1); PG8_BAR; PG8_SCHED;
            PG8_LDA(At, 0, 1); PG8_STAGE(PG8_SB(0, 0), b2, voffB); PG8_STAGE(PG8_SB(0, 1), b2 + hstep, voffB); PG8_STAGE(PG8_SA(0, 0), a2, voffA);
            PG8_WAIT_V(8); PG8_WAIT_L(0); PG8_BAR; PG8_MMA(1, 0, At, B0); PG8_MMA(1, 1, At, B1); PG8_BAR; PG8_SCHED;
            PG8_LDB(B0, 1, 0); PG8_LDB(B1, 1, 1); PG8_SCHED; PG8_LDA(At, 1, 0); PG8_STAGE(PG8_SA(0, 1), a2 + hstepA, voffA);
            PG8_WAIT_V(8); PG8_WAIT_L(0); PG8_BAR; PG8_MMA(0, 0, At, B0); PG8_MMA(0, 1, At, B1); PG8_BAR; PG8_SCHED;
            PG8_LDA(At, 1, 1); PG8_STAGE(PG8_SB(1, 0), b3, voffB); PG8_STAGE(PG8_SB(1, 1), b3 + hstep, voffB); PG8_STAGE(PG8_SA(1, 0), a3, voffA);
            PG8_WAIT_V(8); PG8_WAIT_L(0); PG8_BAR; PG8_MMA(1, 0, At, B0); PG8_MMA(1, 1, At, B1); PG8_BAR; PG8_SCHED;
#else
            PG8_LDB(B0, 0, 0); PG8_SCHED; PG8_LDA(At, 0, 0); PG8_STAGE(PG8_SA(1, 1), a1 + hstepA, voffA);
            PG8_WAIT_L(8); PG8_BAR; PG8_WAIT_L(0); PG8_MMA(0, 0, At, B0); PG8_BAR; PG8_SCHED;
            PG8_LDB(B1, 0, 1); PG8_STAGE(PG8_SB(0, 0), b2, voffB);
            PG8_BAR; PG8_WAIT_L(0); PG8_MMA(0, 1, At, B1); PG8_BAR;
            PG8_LDA(At, 0, 1); PG8_STAGE(PG8_SA(0, 0), a2, voffA);
            PG8_BAR; PG8_WAIT_L(0); PG8_MMA(1, 0, At, B0); PG8_BAR; PG8_SCHED;
            PG8_STAGE(PG8_SB(0, 1), b2 + hstep, voffB);
            PG8_WAIT_V(6); PG8_BAR; PG8_MMA(1, 1, At, B1); PG8_BAR;
            PG8_LDB(B0, 1, 0); PG8_SCHED; PG8_LDA(At, 1, 0); PG8_STAGE(PG8_SA(0, 1), a2 + hstepA, voffA);
            PG8_WAIT_L(8); PG8_BAR; PG8_WAIT_L(0); PG8_MMA(0, 0, At, B0); PG8_BAR; PG8_SCHED;
            PG8_LDB(B1, 1, 1); PG8_STAGE(PG8_SB(1, 0), b3, voffB);
            PG8_BAR; PG8_WAIT_L(0); PG8_MMA(0, 1, At, B1); PG8_BAR;
            PG8_LDA(At, 1, 1); PG8_STAGE(PG8_SA(1, 0), a3, voffA);
            PG8_BAR; PG8_WAIT_L(0); PG8_MMA(1, 0, At, B0); PG8_BAR; PG8_SCHED;
            PG8_STAGE(PG8_SB(1, 1), b3 + hstep, voffB);
            PG8_WAIT_V(6); PG8_BAR; PG8_MMA(1, 1, At, B1); PG8_BAR;
        #endif
        }
#if GEMM_SP2
        if (wr == 0) PG8_BAR;
#endif
        epilogue(acc, cur, E, wr, wc, fr, fq);
        if (!has_next) break;
#pragma unroll
        for (int a = 0; a < 2; ++a)
#pragma unroll
            for (int b = 0; b < 2; ++b)
#pragma unroll
                for (int m = 0; m < 4; ++m)
#pragma unroll
                    for (int n = 0; n < 2; ++n) acc[a][b][m][n] = (f32x4){0.f, 0.f, 0.f, 0.f};
        cur = nxt; cA = nA; cB = nB; ++ui;
#if GEMM_SP2
        if (wr == 1) PG8_BAR;
#endif
    }
    PG8_WAIT_V(0);
#if !GEMM_SP2
    if (wr == 0) PG8_BAR;
#endif
    PG8_BAR;
#undef PG8_SA
#undef PG8_SB
#undef PG8_STAGE
#undef PG8_LDA
#undef PG8_LDB
#undef PG8_MMA
#undef PG8_WAIT_V
#undef PG8_WAIT_L
#undef PG8_BAR
#undef PG8_SCHED
}
}

struct CvJob { const float* src; int ld, K, N; bf16_t* dst; const float* g; int qs; };
constexpr int CT_IN = 16 * 96, CT_O = 16 * 32, CT_UP = 16 * 128, CT_DN = 64 * 32, CT_KV = 16 * 64;
constexpr int CT_TOTAL = 2 * CT_IN + 2 * CT_O + 4 * CT_UP + 4 * CT_DN + CT_O + CT_KV + CT_O + 2 * CT_O;
DI CvJob cv_job(const Params& P, int t, int& local) {
    unsigned char* ws = P.ws; CvJob j;
    if (t < 2 * CT_IN) { const int l = t / CT_IN; local = t % CT_IN; j = {P.fox_w_in + (size_t)l * D * NIN, NIN, D, 3 * D, (bf16_t*)(ws + WS_WT_IN) + (size_t)l * 3 * D * D, P.norm_attn + l * D, D}; return j; } t -= 2 * CT_IN;
    if (t < 2 * CT_O) { const int l = t / CT_O; local = t % CT_O; j = {P.fox_w_o + (size_t)l * D * D, D, D, D, (bf16_t*)(ws + WS_WT_O) + (size_t)l * D * D, nullptr, 0}; return j; } t -= 2 * CT_O;
    if (t < 4 * CT_UP) { const int l = t / CT_UP; local = t % CT_UP; j = {P.w_up + (size_t)l * D * FF, FF, D, FF, (bf16_t*)(ws + WS_WT_UP) + (size_t)l * FF * D, P.norm_mlp + l * D, 0}; return j; } t -= 4 * CT_UP;
    if (t < 4 * CT_DN) { const int l = t / CT_DN; local = t % CT_DN; j = {P.w_down + (size_t)l * FF * D, D, FF, D, (bf16_t*)(ws + WS_WT_DN) + (size_t)l * D * FF, nullptr, 0}; return j; } t -= 4 * CT_DN;
    if (t < CT_O) { local = t; j = {P.sb_w_q, D, D, D, (bf16_t*)(ws + WS_WT_QKV2), P.norm_attn + 2 * D, D}; return j; } t -= CT_O;
    if (t < CT_KV) { local = t; j = {P.w_kv, 2 * D, D, 2 * D, (bf16_t*)(ws + WS_WT_QKV2) + (size_t)D * D, P.kv_norm, 0}; return j; } t -= CT_KV;
    if (t < CT_O) { local = t; j = {P.sb_w_q + (size_t)D * D, D, D, D, (bf16_t*)(ws + WS_WT_Q3), P.norm_attn + 3 * D, D}; return j; } t -= CT_O;
    { const int l = t / CT_O; local = t % CT_O; j = {P.sb_w_o + (size_t)l * D * D, D, D, D, (bf16_t*)(ws + WS_WT_SO) + (size_t)l * D * D, nullptr, 0}; return j; }
}

DI void phase0(const Params& P, LAS unsigned char* lds, int G, int bid) {
    int tid = threadIdx.x; asm volatile("" : "+v"(tid));
    const int lane = tid & 63, w = tid >> 6;
    unsigned char* ws = P.ws;
    {
        u64* ssq = (u64*)(ws + WS_SSQ);
        for (int i = bid * NTHR + tid; i < 8 * MR; i += G * NTHR) ssq[MR + i] = 0ull;
        u64* ssqm = (u64*)(ws + WS_SSQM);
        if (bid == 0 && tid < 8 * 16) ssqm[16 + tid] = 0ull;
        u32x4 z = {0u, 0u, 0u, 0u};
        for (int i = bid * NTHR + tid; i < NB * 12288; i += G * NTHR) { const int b = i / 12288, r = i % 12288; *(u32x4*)(ws + WS_KB + (size_t)b * LP * D * 2 + (size_t)r * 16) = z; }
        for (int i = bid * NTHR + tid; i < D * NB * 6; i += G * NTHR) { const int d = i / (NB * 6), r = i % (NB * 6), b = r / 6, c = r % 6; *(u32x4*)(ws + WS_VT + ((size_t)d * VLD + b * LP) * 2 + c * 16) = z; }
    }
    {
        bf16_t* wf = (bf16_t*)(ws + WS_WF);
        for (int i = bid * NTHR + tid; i < 2 * 16 * D; i += G * NTHR) {
            const int l = i / (16 * D), r = i % (16 * D), k = r / 16, hd = r % 16;
            wf[(size_t)l * 16 * D + (size_t)hd * D + k] = (bf16_t)f2bf(P.norm_attn[l * D + k] * P.fox_w_in[(size_t)l * D * NIN + (size_t)k * NIN + 3 * D + hd]);
        }
    }
    {
        u64* ssq = (u64*)(ws + WS_SSQ); u64* ssqm = (u64*)(ws + WS_SSQM);
        for (int r = bid * 8 + w; r < MR + NMETA; r += G * 8) {
            const bool meta = r >= MR; const int rr = meta ? r - MR : r;
            const f32x4* src = (const f32x4*)((meta ? P.meta : P.x) + (size_t)rr * D) + 2 * lane;
            u32x4* dst = (u32x4*)(ws + (meta ? WS_HBM : WS_HB) + (size_t)rr * D * 2) + lane;
            float s = 0.f;
#pragma unroll
            for (int j = 0; j < 4; ++j) { const f32x4 v = src[128 * j], u = src[128 * j + 1];
                s += (v[0] * v[0] + v[1] * v[1]) + (v[2] * v[2] + v[3] * v[3]) + (u[0] * u[0] + u[1] * u[1]) + (u[2] * u[2] + u[3] * u[3]);
                u32x4 o; o.x = pk2(v[0], v[1]); o.y = pk2(v[2], v[3]); o.z = pk2(u[0], u[1]); o.w = pk2(u[2], u[3]); dst[64 * j] = o; }
            s = wave_sum(s);
            if (lane == 0) { if (meta) ssqm[rr] = ssq_fix(s); else ssq[rr] = ssq_fix(s); }
        }
    }
    {
        LAS unsigned* T = (LAS unsigned*)lds;
        f32x4 ra[2][2], rb[2][2];
        bf16_t *da = nullptr, *db = nullptr; const float *ga = nullptr, *gb = nullptr; int Ka = 0, Kb = 0; bool sa = false, sb = false;
#define CV_LOAD(R, DST, GP, KD, SC, tt) do { int local_; const CvJob j_ = cv_job(P, (tt), local_); \
            const int nnt_ = j_.N / 64, k0_ = (local_ / nnt_) * 128, n0_ = (local_ % nnt_) * 64; \
            _Pragma("unroll") for (int p = 0; p < 2; ++p) { const int idx = tid + NTHR * p, kp = idx >> 4, nq = idx & 15; \
                const float* s_ = j_.src + (size_t)(k0_ + 2 * kp) * j_.ld + n0_ + 4 * nq; \
                R[p][0] = __builtin_nontemporal_load((const f32x4*)s_); R[p][1] = __builtin_nontemporal_load((const f32x4*)(s_ + j_.ld)); } \
            DST = j_.dst + (size_t)n0_ * j_.K + k0_; GP = j_.g ? j_.g + k0_ : nullptr; KD = j_.K; SC = n0_ < j_.qs; } while (0)
#define CV_CONVERT(R, GP, SC) do { _Pragma("unroll") for (int p = 0; p < 2; ++p) { const int idx = tid + NTHR * p, kp = idx >> 4, nq = idx & 15; \
                float g0 = 1.f, g1 = 1.f; if (GP) { g0 = GP[2 * kp]; g1 = GP[2 * kp + 1]; } \
                if (SC) { g0 *= QSCALE; g1 *= QSCALE; } \
                _Pragma("unroll") for (int i = 0; i < 4; ++i) T[(4 * nq + i) * 65 + kp] = pk2(R[p][0][i] * g0, R[p][1][i] * g1); } } while (0)
#define CV_STORE(DST, KD) do { _Pragma("unroll") for (int p = 0; p < 2; ++p) { const int idx = tid + NTHR * p, n = idx >> 4, kq = idx & 15; \
                u32x4 o; o.x = T[n * 65 + 4 * kq]; o.y = T[n * 65 + 4 * kq + 1]; o.z = T[n * 65 + 4 * kq + 2]; o.w = T[n * 65 + 4 * kq + 3]; \
                *(u32x4*)(DST + (size_t)n * KD + 8 * kq) = o; } } while (0)
        int t = bid;
        if (t < CT_TOTAL) CV_LOAD(ra, da, ga, Ka, sa, t);
        if (t + G < CT_TOTAL) CV_LOAD(rb, db, gb, Kb, sb, t + G);
        while (t < CT_TOTAL) {
            { bf16_t* cd = da; const int ck = Ka;
              CV_CONVERT(ra, ga, sa);
              if (t + 2 * G < CT_TOTAL) CV_LOAD(ra, da, ga, Ka, sa, t + 2 * G);
              __syncthreads();
              CV_STORE(cd, ck);
              __syncthreads(); }
            if (t + G >= CT_TOTAL) break;
            { bf16_t* cd = db; const int ck = Kb;
              CV_CONVERT(rb, gb, sb);
              if (t + 3 * G < CT_TOTAL) CV_LOAD(rb, db, gb, Kb, sb, t + 3 * G);
              __syncthreads();
              CV_STORE(cd, ck);
              __syncthreads(); }
            t += 2 * G;
        }
#undef CV_LOAD
#undef CV_CONVERT
#undef CV_STORE
    }
}

DI void compute_c2(const float* LF, int b, int h, LAS float* c2, LAS float* wtot) {
    int tid = threadIdx.x; asm volatile("" : "+v"(tid));
    const int lane = tid & 63, w = tid >> 6;
    const float* src = LF + ((size_t)b * NH + h) * LP;
    const int cbeg = w * 264, cend = cbeg + 264, p0 = cbeg + lane * 5;
    float v[5]; float run = 0.f;
#pragma unroll
    for (int e = 0; e < 5; ++e) { const int pos = p0 + e; const float x = (pos >= MOFF && pos < cend) ? src[pos] : 0.f; run += x; v[e] = run; }
    float incl = run;
#pragma unroll
    for (int o = 1; o < 64; o <<= 1) { const float t = __shfl_up(incl, o); if (lane >= o) incl += t; }
    const float excl = incl - run;
    if (lane == 63) wtot[w] = incl;
    __syncthreads();
    float wp = 0.f;
    for (int i = 0; i < w; ++i) wp += wtot[i];
#pragma unroll
    for (int e = 0; e < 5; ++e) { const int pos = p0 + e; if (pos < cend) c2[pos] = (pos < MOFF) ? __builtin_inff() : (wp + excl + v[e]) * LOG2E; }
    __syncthreads();
}

template <int TYPE>
DI void naive_attn_row(const unsigned char* ws, int b, int h, const bf16_t* qptr, int qpos, bf16_t* optr, const LAS float* c2, LAS float* sc, LAS float* qf) {
    int tid_ = threadIdx.x; asm volatile("" : "+v"(tid_));
    const int lane = tid_ & 63;
    const bf16_t* KB = (const bf16_t*)(ws + WS_KB); const bf16_t* VT = (const bf16_t*)(ws + WS_VT);
    { const unsigned qq = *(const unsigned*)(qptr + 2 * lane); qf[2 * lane] = bflo(qq); qf[2 * lane + 1] = bfhi(qq); }
    lds_fence();
    const int nkeys = (TYPE == 0) ? (qpos - MOFF + 1) : (qpos - MOFF);
    const int nk8 = (nkeys + 7) & ~7;
    for (int j = lane; j < nk8; j += 64) {
        float dot = 0.f;
        if (j < nkeys) {
            const u32x4* kp = (const u32x4*)(KB + ((size_t)b * LP + MOFF + j) * D + h * DH);
#pragma unroll 4
            for (int c = 0; c < 16; ++c) { const u32x4 kv = kp[c]; const f32x4 q0 = *(const LAS f32x4*)(qf + 8 * c), q1 = *(const LAS f32x4*)(qf + 8 * c + 4);
                dot += bflo(kv.x) * q0[0] + bfhi(kv.x) * q0[1] + bflo(kv.y) * q0[2] + bfhi(kv.y) * q0[3] + bflo(kv.z) * q1[0] + bfhi(kv.z) * q1[1] + bflo(kv.w) * q1[2] + bfhi(kv.w) * q1[3]; }
        }
        sc[j] = dot;
    }
    lds_fence();
    float inv = 1.f;
    if (TYPE == 0) {
        float m = -__builtin_inff();
        for (int j = lane; j < nkeys; j += 64) m = fmaxf(m, sc[j] - c2[MOFF + j]);
        m = wave_max(m);
        float l = 0.f;
        for (int j = lane; j < nk8; j += 64) { const float p = (j < nkeys) ? ex2(sc[j] - c2[MOFF + j] - m) : 0.f; l += p; sc[j] = p; }
        l = wave_sum(l); inv = 1.f / l;
    } else {
        float carry = 0.f;
        for (int top = nk8 - 1; top >= 0; top -= 64) {
            const int j = top - lane; const bool valid = (j >= 0) && (j < nkeys);
            const float y = (j >= 0) ? sc[j] : 0.f;
            const float sp = fmaxf(y, 0.f) + lg2(1.f + ex2(-fabsf(y)));
            const float lom = valid ? -sp : 0.f;
            float incl = lom;
#pragma unroll
            for (int o = 1; o < 64; o <<= 1) { const float t = __shfl_up(incl, o); if (lane >= o) incl += t; }
            const float a = valid ? ex2(y - sp + carry + (incl - lom)) : 0.f;
            if (j >= 0) sc[j] = a;
            carry += __shfl(incl, 63);
        }
    }
    lds_fence();
    float o0 = 0.f, o1 = 0.f;
    const bf16_t* v0 = VT + (size_t)(h * DH + 2 * lane) * VLD + b * LP + MOFF; const bf16_t* v1 = v0 + VLD;
#pragma unroll 2
    for (int j = 0; j < nk8; j += 8) {
        const u32x4 a = *(const u32x4*)(v0 + j), c = *(const u32x4*)(v1 + j);
        const f32x4 p0 = *(const LAS f32x4*)(sc + j), p1 = *(const LAS f32x4*)(sc + j + 4);
        o0 += bflo(a.x) * p0[0] + bfhi(a.x) * p0[1] + bflo(a.y) * p0[2] + bfhi(a.y) * p0[3] + bflo(a.z) * p1[0] + bfhi(a.z) * p1[1] + bflo(a.w) * p1[2] + bfhi(a.w) * p1[3];
        o1 += bflo(c.x) * p0[0] + bfhi(c.x) * p0[1] + bflo(c.y) * p0[2] + bfhi(c.y) * p0[3] + bflo(c.z) * p1[0] + bfhi(c.z) * p1[1] + bflo(c.w) * p1[2] + bfhi(c.w) * p1[3];
    }
    *(unsigned*)(optr + 2 * lane) = pk2(o0 * inv, o1 * inv);
    lds_fence();
}

constexpr int AT_C2 = 0, AT_WTOT = 8448, AT_K0 = 8704, AT_KSZ = 64 * 272, AT_V0 = AT_K0 + 2 * AT_KSZ, AT_VSZ = 128 * 144;
constexpr int NA_SC = 8704, NA_QF = NA_SC + 8 * 2064 * 4;
static_assert(AT_V0 + 3 * AT_VSZ <= 131072 && NA_QF + 8 * 128 * 4 <= 131072, "attention LDS");

DI int swap23(int m) { return (m & 0x13) | ((m & 4) << 1) | ((m & 8) >> 1); }

template <int TYPE>
DI void attn_item(const unsigned char* ws_in, LAS unsigned char* lds, int b, int h, int qb) {
    const unsigned char* ws = ws_in + opaque0();
    int tid = threadIdx.x; asm volatile("" : "+v"(tid));
    const int lane = tid & 63, w = __builtin_amdgcn_readfirstlane(tid >> 6), m32 = lane & 31, g = lane >> 5;
    const bf16_t* QB = (const bf16_t*)(ws + WS_QB); const bf16_t* KB = (const bf16_t*)(ws + WS_KB); const bf16_t* VT = (const bf16_t*)(ws + WS_VT);
    bf16_t* OB = (bf16_t*)(ws + WS_OB);
    const LAS float* c2 = (const LAS float*)(lds + AT_C2);
    const int nkt = 4 * qb + 5;
    const int prow0 = ROFF + 256 * qb + 32 * w, plast = prow0 + 31, qp = prow0 + m32;
    const int tok = b * SEQ + 256 * qb + 32 * w + m32;
    bf16x8 Q[8];
    { const bf16_t* qptr = QB + (size_t)tok * D + h * DH + 8 * g;
#pragma unroll
      for (int ks = 0; ks < 8; ++ks) Q[ks] = *(const bf16x8*)(qptr + 16 * ks); }
    f32x16 O[4];
#pragma unroll
    for (int i = 0; i < 4; ++i)
#pragma unroll
        for (int a = 0; a < 16; ++a) O[i][a] = 0.f;
    float mrun = -__builtin_inff(), lrun = 0.f, carry = 1.f;
    u32x4 kreg[2], vreg[2];
    const bf16_t* kbase = KB + (size_t)b * LP * D + h * DH;
    const bf16_t* vbase = VT + (size_t)h * DH * VLD + b * LP;
#define AT_LOAD(kt) do { _Pragma("unroll") for (int i = 0; i < 2; ++i) { const int ch = tid + NTHR * i; \
        kreg[i] = *(const u32x4*)(kbase + (size_t)(64 * (kt) + (ch >> 4)) * D + 8 * (ch & 15)); \
        vreg[i] = *(const u32x4*)(vbase + (size_t)(ch >> 3) * VLD + 64 * (kt) + 8 * (ch & 7)); } } while (0)
#define AT_STORE(kbuf, vbuf) do { _Pragma("unroll") for (int i = 0; i < 2; ++i) { const int ch = tid + NTHR * i; \
        *(LAS u32x4*)(lds + AT_K0 + (kbuf) * AT_KSZ + (ch >> 4) * 272 + (ch & 15) * 16) = kreg[i]; \
        *(LAS u32x4*)(lds + AT_V0 + (vbuf) * AT_VSZ + (ch >> 3) * 144 + (ch & 7) * 16) = vreg[i]; } } while (0)
#define AT_PV(vbuf) do { const LAS unsigned char* vb_ = lds + AT_V0 + (vbuf) * AT_VSZ; \
        _Pragma("unroll") for (int db = 0; db < 4; ++db) _Pragma("unroll") for (int blk = 0; blk < 2; ++blk) _Pragma("unroll") for (int s = 0; s < 2; ++s) { \
            const bf16x8 vf = *(const LAS bf16x8*)(vb_ + (32 * db + m32) * 144 + 64 * blk + 32 * s + 16 * g); \
            O[db] = __builtin_amdgcn_mfma_f32_32x32x16_bf16(vf, Pf[blk][s], O[db], 0, 0, 0); } } while (0)
    __syncthreads();
    if (TYPE == 1 && tid < 3) ((volatile LAS unsigned*)(lds + AT_WTOT))[tid] = 0u;
    { const int kt0 = (TYPE == 0) ? 0 : nkt - 1; AT_LOAD(kt0); AT_STORE(0, 0); }
    __syncthreads();
    const int krow = swap23(m32);
    const bool grpB = (w >= 4);
    bf16x8 Pf[2][2];
    bool pend = false; int vprev = 0, vcur = 0;
    volatile LAS unsigned* dcnt = (volatile LAS unsigned*)(lds + AT_WTOT);
    bool wdone = false; int dc = 0;
    for (int it = 0; it <= nkt; ++it) {
        if (TYPE == 1) {
            const int dn = (dc == 2) ? 0 : dc + 1, dz = (dn == 2) ? 0 : dn + 1;
            if (dcnt[dc] == 8u) { if (pend) { AT_PV(vprev); pend = false; } break; }
            if (tid == 0) dcnt[dz] = 0u;
            if (wdone && lane == 0) __hip_atomic_fetch_add((LAS unsigned*)(lds + AT_WTOT) + dn, 1u, __ATOMIC_RELAXED, __HIP_MEMORY_SCOPE_WORKGROUP);
            dc = dn;
        }
        const bool have = it < nkt;
        const int kt = (TYPE == 0) ? it : nkt - 1 - it, cur = it & 1;
        const bool more = it + 1 < nkt;
        const int vnext = (vcur == 2) ? 0 : vcur + 1;
        if (more) { const int ktn = (TYPE == 0) ? it + 1 : nkt - 2 - it; AT_LOAD(ktn); }
        if (pend) { AT_PV(vprev); pend = false; }
        if (have && 64 * kt <= plast && !wdone) {
            const LAS unsigned char* kb = lds + AT_K0 + cur * AT_KSZ;
            f32x16 S[2];
#pragma unroll
            for (int blk = 0; blk < 2; ++blk) {
                if (TYPE == 0) {
#pragma unroll
                    for (int s = 0; s < 2; ++s) { const int kp0 = 64 * kt + 32 * blk + 16 * s + 8 * g;
                        const f32x4 ca = *(const LAS f32x4*)(c2 + kp0), cb = *(const LAS f32x4*)(c2 + kp0 + 4);
#pragma unroll
                        for (int e = 0; e < 4; ++e) { S[blk][8 * s + e] = -ca[e]; S[blk][8 * s + 4 + e] = -cb[e]; } }
                } else {
#pragma unroll
                    for (int a = 0; a < 16; ++a) S[blk][a] = 0.f;
                }
#pragma unroll
                for (int ks = 0; ks < 8; ++ks) {
                    const bf16x8 kf = *(const LAS bf16x8*)(kb + (32 * blk + krow) * 272 + 32 * ks + 16 * g);
                    S[blk] = __builtin_amdgcn_mfma_f32_32x32x16_bf16(kf, Q[ks], S[blk], 0, 0, 0);
                }
            }
            const bool diag = (64 * kt + 63 >= prow0);
            if (TYPE == 0) {
                float mx = -__builtin_inff();
#define FOX_SCORE(MASKED) _Pragma("unroll") for (int blk = 0; blk < 2; ++blk) _Pragma("unroll") for (int s = 0; s < 2; ++s) { \
                        const int kp0 = 64 * kt + 32 * blk + 16 * s + 8 * g; \
                        _Pragma("unroll") for (int e = 0; e < 8; ++e) { \
                            float sv = S[blk][8 * s + e]; \
                            if (MASKED) { if (kp0 + e > qp) sv = -__builtin_inff(); } \
                            S[blk][8 * s + e] = sv; mx = fmaxf(mx, sv); } }
                if (diag) { FOX_SCORE(true) } else { FOX_SCORE(false) }
#undef FOX_SCORE
                mx = fmaxf(mx, xor32(mx, lane));
                const float mnew = fmaxf(mrun, mx);
                const float alpha = ex2(mrun - mnew);
                mrun = mnew;
                float rs = 0.f;
#pragma unroll
                for (int blk = 0; blk < 2; ++blk)
#pragma unroll
                    for (int s = 0; s < 2; ++s) {
                        float p[8];
#pragma unroll
                        for (int e = 0; e < 8; ++e) { p[e] = ex2(S[blk][8 * s + e] - mnew); rs += p[e]; }
                        u32x4 pw; pw.x = pk2(p[0], p[1]); pw.y = pk2(p[2], p[3]); pw.z = pk2(p[4], p[5]); pw.w = pk2(p[6], p[7]);
                        Pf[blk][s] = __builtin_bit_cast(bf16x8, pw);
                    }
                lrun = lrun * alpha + rs;
                if (__builtin_amdgcn_ballot_w64(alpha != 1.0f) != 0ull) {
#pragma unroll
                    for (int i = 0; i < 4; ++i)
#pragma unroll
                        for (int a = 0; a < 16; ++a) O[i][a] *= alpha;
                }
            } else {
                float T[2][2];
                const unsigned qlim = (unsigned)(qp - MOFF);
                const bool msk = diag || kt == 0;
#pragma unroll
                for (int blk = 0; blk < 2; ++blk)
#pragma unroll
                    for (int s = 0; s < 2; ++s) {
                        const int kp0 = 64 * kt + 32 * blk + 16 * s + 8 * g;
                        float run = 1.f;
#pragma unroll
                        for (int e = 7; e >= 0; --e) {
                            float y = S[blk][8 * s + e];
                            if (msk) y = ((unsigned)(kp0 + e - MOFF) < qlim) ? y : -126.f;
                            const float t = ex2(-fmaxf(y, -126.f));
                            const float beta = __builtin_amdgcn_rcpf(1.f + t), omb = t * beta;
                            S[blk][8 * s + e] = beta * run; run *= omb;
                        }
                        T[blk][s] = run;
                    }
                float PT[2][2];
#pragma unroll
                for (int blk = 0; blk < 2; ++blk)
#pragma unroll
                    for (int s = 0; s < 2; ++s) PT[blk][s] = xor32(T[blk][s], lane);
                float off[2][2]; float accu = carry;
#pragma unroll
                for (int blk = 1; blk >= 0; --blk)
#pragma unroll
                    for (int s = 1; s >= 0; --s) { off[blk][s] = (g == 0) ? accu * PT[blk][s] : accu; accu *= T[blk][s] * PT[blk][s]; }
                carry = accu;
                if (__builtin_amdgcn_ballot_w64(carry >= 7.888609e-31f) == 0ull) { wdone = true;
                    if (lane == 0) __hip_atomic_fetch_add((LAS unsigned*)(lds + AT_WTOT) + dc, 1u, __ATOMIC_RELAXED, __HIP_MEMORY_SCOPE_WORKGROUP); }
#pragma unroll
                for (int blk = 0; blk < 2; ++blk)
#pragma unroll
                    for (int s = 0; s < 2; ++s) {
                        float p[8];
#pragma unroll
                        for (int e = 0; e < 8; ++e) p[e] = S[blk][8 * s + e] * off[blk][s];
                        u32x4 pw; pw.x = pk2(p[0], p[1]); pw.y = pk2(p[2], p[3]); pw.z = pk2(p[4], p[5]); pw.w = pk2(p[6], p[7]);
                        Pf[blk][s] = __builtin_bit_cast(bf16x8, pw);
                    }
            }
            if (grpB) { pend = true; vprev = vcur; } else { AT_PV(vcur); }
        }
        if (more) AT_STORE(cur ^ 1, vnext);
        __syncthreads();
        vcur = vnext;
    }
#undef AT_LOAD
#undef AT_STORE
#undef AT_PV
    float inv = 1.f;
    if (TYPE == 0) { const float lt = lrun + xor32(lrun, lane); inv = 1.f / lt; }
    bf16_t* op = OB + (size_t)tok * D + h * DH + 8 * g;
#pragma unroll
    for (int db = 0; db < 4; ++db)
#pragma unroll
        for (int j = 0; j < 2; ++j) {
            const unsigned ax = pk2(O[db][8 * j] * inv, O[db][8 * j + 1] * inv), ay = pk2(O[db][8 * j + 2] * inv, O[db][8 * j + 3] * inv);
            const unsigned bx = pk2(O[db][8 * j + 4] * inv, O[db][8 * j + 5] * inv), by = pk2(O[db][8 * j + 6] * inv, O[db][8 * j + 7] * inv);
            const auto rx = __builtin_amdgcn_permlane32_swap(ax, bx, false, false), ry = __builtin_amdgcn_permlane32_swap(ay, by, false, false);
            u32x4 o; o.x = rx[0]; o.y = ry[0]; o.z = rx[1]; o.w = ry[1];
            *(u32x4*)(op + 32 * db + 16 * j) = o;
        }
}

DI void attn_phase(const Params& P, LAS unsigned char* lds, int layer, int G, int bid, int vcu) {
    int tid = threadIdx.x; asm volatile("" : "+v"(tid));
    const int w = tid >> 6;
    const unsigned char* ws = P.ws + opaque0();
    const float* LF = (const float*)(ws + WS_LF);
    LAS float* c2 = (LAS float*)(lds + AT_C2); LAS float* wtot = (LAS float*)(lds + AT_WTOT);
    LAS float* sc = (LAS float*)(lds + NA_SC) + w * 2064; LAS float* qf = (LAS float*)(lds + NA_QF) + w * 128;
    const bool fox = layer < 2;
    if (fox) {
        for (int it = bid; it < 32; it += G) {
            const int h = it >> 1, r = (it & 1) * 8 + w;
            compute_c2(LF, 0, h, c2, wtot);
            naive_attn_row<0>(ws, 0, h, (const bf16_t*)(ws + WS_QM) + (size_t)r * D + h * DH, MOFF + r, (bf16_t*)(P.ws + WS_OM) + (size_t)r * D + h * DH, c2, sc, qf);
            __syncthreads();
        }
    }
    const bool naive = fox ? (NAIVE_FOX != 0) : (NAIVE_SB != 0);
    if (naive) {
        for (int it = bid; it < NB * NH * 256; it += G) {
            const int bh = it >> 8, b = bh >> 4, h = bh & 15, t = (it & 255) * 8 + w;
            if (fox) compute_c2(LF, b, h, c2, wtot);
            const bf16_t* qptr = (const bf16_t*)(ws + WS_QB) + (size_t)(b * SEQ + t) * D + h * DH; bf16_t* optr = (bf16_t*)(P.ws + WS_OB) + (size_t)(b * SEQ + t) * D + h * DH;
            if (fox) naive_attn_row<0>(ws, b, h, qptr, ROFF + t, optr, c2, sc, qf); else naive_attn_row<1>(ws, b, h, qptr, ROFF + t, optr, c2, sc, qf);
            __syncthreads();
        }
    } else {
        for (int it = vcu; it < NB * NH * 4; it += G) {
            const int bh = it >> 2, b = bh >> 4, h = bh & 15, p = it & 3;
            if (fox) { __syncthreads(); compute_c2(LF, b, h, c2, wtot);
#pragma nounroll
                for (int hf = 0; hf < 2; ++hf) attn_item<0>(ws, lds, b, h, hf ? p : 7 - p); }
            else {
#pragma nounroll
                for (int hf = 0; hf < 2; ++hf) attn_item<1>(ws, lds, b, h, hf ? p : 7 - p); }
        }
    }
    __syncthreads();
}

DI EpiCtx make_epi(const Params& P, unsigned char* ws, int l, int kind) {
    u64* ssq = (u64*)(ws + WS_SSQ); u64* ssqm = (u64*)(ws + WS_SSQM);
    EpiCtx e{}; e.ws = ws; e.bfg = P.fox_b_f + (l < 2 ? l : 0) * NH; e.rsc = 1.f;
    e.ssq_in = ssq; e.ssqm_in = ssqm; e.ssq_out = ssq; e.ssqm_out = ssqm; e.hin = nullptr; e.hmin = (const float*)(ws + WS_HM);
    if (kind == 0) { e.ssq_in = ssq + (size_t)(2 * l) * MR; e.ssqm_in = ssqm + (2 * l) * 16; }
    else if (kind == 2) { if (l == 0) { e.hmin = P.meta; }     e.ssq_out = ssq + (size_t)(2 * l + 1) * MR; e.ssqm_out = ssqm + (2 * l + 1) * 16; }
    else if (kind == 3) { e.ssq_in = ssq + (size_t)(2 * l + 1) * MR; e.ssqm_in = ssqm + (2 * l + 1) * 16; }
    else { e.ssq_out = ssq + (size_t)(2 * l + 2) * MR; e.ssqm_out = ssqm + (2 * l + 2) * 16; }
    return e;
}
DI const bf16_t* phase_w(unsigned char* ws, int l, int kind) {
    if (kind == 0) return (l < 2) ? (const bf16_t*)(ws + WS_WT_IN) + (size_t)l * 3 * D * D : (l == 2 ? (const bf16_t*)(ws + WS_WT_QKV2) : (const bf16_t*)(ws + WS_WT_Q3));
    if (kind == 2) return (l < 2) ? (const bf16_t*)(ws + WS_WT_O) + (size_t)l * D * D : (const bf16_t*)(ws + WS_WT_SO) + (size_t)(l - 2) * D * D;
    if (kind == 3) return (const bf16_t*)(ws + WS_WT_UP) + (size_t)l * FF * D;
    return (const bf16_t*)(ws + WS_WT_DN) + (size_t)l * D * FF;
}
DI pg8::Sched make_sched(unsigned char* ws, int l, int kind, int G, int bid) {
    pg8::Sched S{}; S.G = G; S.c = bid; S.K = (kind == 4) ? FF : D;
    const bf16_t* W = phase_w(ws, l, kind); const bf16_t* HB = (const bf16_t*)(ws + WS_HB);
    S.A0 = HB; S.B0 = W; S.nM0 = 32; S.nN0 = 8; S.ek0 = E_RES; S.A1 = W; S.B1 = HB; S.nM1 = 0; S.nN1 = 0; S.ek1 = E_VT;
    if (kind == 0) { S.nN0 = (l < 3) ? 16 : 8; S.ek0 = E_QK; if (l < 3) { S.A1 = W + (size_t)2 * D * D; S.nM1 = 8; S.nN1 = 32; } }
    else if (kind == 2) { S.A0 = (const bf16_t*)(ws + WS_OB); }
    else if (kind == 3) { S.nN0 = 32; S.ek0 = E_UP; }
    else { S.A0 = (const bf16_t*)(ws + WS_UB); S.ablk = !NAIVE_GEMM; }
    return S;
}
DI SkJob make_job(unsigned char* ws, int l, int kind, int q) {
    SkJob j{}; j.kind = JK_NONE;
    const bf16_t* W = phase_w(ws, l, kind); const bf16_t* HB = (const bf16_t*)(ws + WS_HB); const bf16_t* HBM = (const bf16_t*)(ws + WS_HBM);
    if (q == 0) {
        if (kind == 0) { if (l < 2) j = {HBM, W, D, 384, JK_META_IN, 0, 0, 0, 0}; else if (l == 2) j = {HBM, W + (size_t)D * D, D, 256, JK_META_IN, D, 0, 0, 0}; }
        else if (l < 2) {
            if (kind == 2) j = {(const bf16_t*)(ws + WS_OM), W, D, 128, JK_META_RES, 0, 0, 0, 0};
            else if (kind == 3) j = {HBM, W, D, 512, JK_META_UP, 0, 0, 0, 0};
            else j = {(const bf16_t*)(ws + WS_UM), W, FF, 128, JK_META_RES, 0, 0, 0, 0};
        }
    } else if (q <= 2) {
        if (kind == 0 && l < 2) {
            const bf16_t* WF = (const bf16_t*)(ws + WS_WF) + (size_t)l * 16 * D;
            if (q == 1) j = {WF, HB, D, MR / 16, JK_FG, 0, 0, 0, 0}; else j = {WF, HBM, D, 1, JK_FG_META, 0, 0, 0, 0};
        }
    } else {
        const pg8::Sched S = make_sched(ws, l, kind, 1, 0);
        if (q == 3) j = {S.A0, S.B0, S.K, S.nM0 * 16 * S.nN0 * 16, JK_NAIVE, 0, S.ek0, S.nN0 * 16, 0};
        else j = {S.A1, S.B1, S.K, S.nM1 * 16 * S.nN1 * 16, JK_NAIVE, 0, S.ek1, S.nN1 * 16, 0};
    }
    return j;
}

__global__ void __launch_bounds__(NTHR, 2) yoco_mega(Params P) {
    extern __shared__ __attribute__((aligned(16))) unsigned char smem[];
    LAS unsigned char* lds = (LAS unsigned char*)smem;
    cg::grid_group grid = cg::this_grid();
    const int G = gridDim.x, bid = blockIdx.x;
    unsigned char* ws = P.ws;
    const unsigned xcc = (unsigned)__builtin_amdgcn_s_getreg((3 << 11) | 20) & 7u;
    {
        LAS unsigned* lw = (LAS unsigned*)(lds + LDS_BYTES - 16);
        if (threadIdx.x == 0) lw[0] = __hip_atomic_fetch_add((unsigned*)(ws + WS_BAR) + 8 + xcc, 1u, __ATOMIC_RELAXED, __HIP_MEMORY_SCOPE_AGENT);
        __syncthreads();
    }
    const unsigned xrank = __builtin_amdgcn_readfirstlane(((LAS unsigned*)(lds + LDS_BYTES - 16))[0]);
    phase0(P, lds, G, bid);
#if DUP_P0
    __syncthreads(); phase0(P, lds, G, bid);
#endif
    asm volatile("s_waitcnt vmcnt(0) lgkmcnt(0)" ::: "memory");
    grid.sync();
    unsigned* barcnt = (unsigned*)(ws + WS_BAR); unsigned nbar = 0;
    int vcu;
    bool xok; unsigned kx = 0;
    {
        bool ok = (G == 256);
        for (int i = 0; i < 8; ++i) ok = ok && (__hip_atomic_load((unsigned*)(ws + WS_BAR) + 8 + i, __ATOMIC_RELAXED, __HIP_MEMORY_SCOPE_AGENT) == 32u);
        vcu = ok ? (int)(xcc * 32u + xrank) : ((G % 8 == 0) ? (bid % 8) * (G / 8) + bid / 8 : bid);
        xok = ok;
    }
#define GBAR() do { if (xok) grid_bar_x(barcnt, xcc, ++kx); else grid_bar(barcnt, ++nbar * (unsigned)G); } while (0)
    const int vc = (G % 8 == 0) ? (vcu % (G / 8)) * 8 + vcu / (G / 8) : vcu;
#pragma nounroll
    for (int step0 = 0; step0 < 20 + DUP_STEP; ++step0) {
        const int step = (DUP_STEP && step0 > DUP_STEP_AT) ? step0 - 1 : step0;
        const int l = step / 5, kind = step % 5;
        if (kind == 1) { attn_phase(P, lds, l, G, bid, vcu);
#if DUP_FOX
            if (l == 0) attn_phase(P, lds, l, G, bid, vcu);
#endif
#if DUP_SB
            if (l == 2) attn_phase(P, lds, l, G, bid, vcu);
#endif
        }
        else {
#if !NAIVE_GEMM
            {
                unsigned char* wsl = P.ws + opaque0();
                const EpiCtx e = make_epi(P, wsl, l, kind);
                const pg8::Sched S = make_sched(wsl, l, kind, G, vc);
                pg8::gemm_phase(lds, S, e);
#if DUP_UP
                if (kind == 3 && l == 0) pg8::gemm_phase(lds, S, e);
#endif
#if DUP_RES
                if (kind == DUP_RES && l == 0) { GBAR(); EpiCtx e2 = e; e2.rsc = 0.f; e2.hin = nullptr; pg8::Sched S2 = S; S2.pmmask = DUP_PMMASK; pg8::gemm_phase(lds, S2, e2); }
#endif
            }
#endif
#pragma nounroll
            for (int q = 0; q < (NAIVE_GEMM ? 5 : 3); ++q) {
                unsigned char* wsl = P.ws + opaque0();
                const EpiCtx e = make_epi(P, wsl, l, kind);
                const SkJob jb = make_job(wsl, l, kind, q);
                skinny_items(jb, e, lds, G, bid);
            }
        }
        GBAR();
    }
#if DUP_BAR
    for (int i = 0; i < DUP_BAR; ++i) GBAR();
#endif
    {
        int tid = threadIdx.x; asm volatile("" : "+v"(tid));
        const int lane = tid & 63, w = tid >> 6;
        const u64* ssq = (const u64*)(ws + WS_SSQ) + (size_t)8 * MR; const bf16_t* hb = (const bf16_t*)(ws + WS_HB);
        for (int r = bid * 8 + w; r < MR; r += G * 8) {
            const float rs = rstd_of(ssq[r]);
            const u32x4* src = (const u32x4*)(hb + (size_t)r * D) + lane; const f32x4* gg = (const f32x4*)P.final_norm; f32x4* dst = (f32x4*)(P.out + (size_t)r * D);
#pragma unroll
            for (int j = 0; j < 4; ++j) {
                const u32x4 t = src[64 * j]; const int c4 = (lane + 64 * j) * 2;
                const f32x4 a0 = {bflo(t.x), bfhi(t.x), bflo(t.y), bfhi(t.y)}, a1 = {bflo(t.z), bfhi(t.z), bflo(t.w), bfhi(t.w)};
                dst[c4] = a0 * rs * gg[c4]; dst[c4 + 1] = a1 * rs * gg[c4 + 1];
            }
        }
    }
}

extern "C" void kernel_launch(void* const* d_in, const int* in_sizes, int n_in, void* d_out, int out_size, void* d_ws, size_t ws_size, hipStream_t stream) {
    static int grid = 0;
    if (grid == 0) {
        if (n_in != 14 || out_size != MR * D || ws_size < WS_END) { fprintf(stderr, "kernel_launch: unexpected shapes (n_in %d out %d ws %zu need %zu)\n", n_in, out_size, ws_size, (size_t)WS_END); grid = -1; return; }
        int dev = 0, cus = 0, per_cu = 0;
        hipGetDevice(&dev);
        hipDeviceGetAttribute(&cus, hipDeviceAttributeMultiprocessorCount, dev);
        if (hipFuncSetAttribute((const void*)yoco_mega, hipFuncAttributeMaxDynamicSharedMemorySize, LDS_BYTES) != hipSuccess) { fprintf(stderr, "kernel_launch: hipFuncSetAttribute failed\n"); grid = -1; return; }
        hipOccupancyMaxActiveBlocksPerMultiprocessor(&per_cu, (const void*)yoco_mega, NTHR, LDS_BYTES);
        (void)hipGetLastError();
        if (per_cu < 1) per_cu = 1;
        grid = cus * 1;
        fprintf(stderr, "kernel_launch: cus %d per_cu %d grid %d\n", cus, per_cu, grid);
    }
    if (grid < 0) return;
    Params p{};
    p.x = (const float*)d_in[0]; p.meta = (const float*)d_in[1]; p.norm_attn = (const float*)d_in[2]; p.norm_mlp = (const float*)d_in[3];
    p.w_up = (const float*)d_in[4]; p.w_down = (const float*)d_in[5]; p.fox_w_in = (const float*)d_in[6]; p.fox_b_f = (const float*)d_in[7];
    p.fox_w_o = (const float*)d_in[8]; p.kv_norm = (const float*)d_in[9]; p.w_kv = (const float*)d_in[10]; p.sb_w_q = (const float*)d_in[11];
    p.sb_w_o = (const float*)d_in[12]; p.final_norm = (const float*)d_in[13];
    p.out = (float*)d_out; p.ws = (unsigned char*)d_ws;
    if (hipMemsetAsync((unsigned char*)d_ws + WS_BAR, 0, 256, stream) != hipSuccess) { fprintf(stderr, "kernel_launch: memset failed\n"); return; }
    void* args[] = {&p};
    hipError_t e = hipLaunchCooperativeKernel((const void*)yoco_mega, dim3(grid), dim3(NTHR), args, LDS_BYTES, stream);
    if (e != hipSuccess) fprintf(stderr, "cooperative launch failed: %s (grid %d)\n", hipGetErrorString(e), grid);
}
```
